# Optimizing an MI355X kernel written in HIP

```python
import jax, jax.numpy as jnp
from jax import lax
import numpy as np

D_MODEL = 1024
BATCH = 8
SEQ = 4096
DEPTH = 4

HEAD_DIM = 64
FOX_HEADS = 8
FOX_WIDTH = FOX_HEADS * HEAD_DIM
POOL_GROUPS = 4
POOL_WINDOWS = (2, 4, 8, 16)
POOL_WIDTH = D_MODEL - FOX_WIDTH
POOL_GROUP_DIM = POOL_WIDTH // POOL_GROUPS
Q_BLOCK = 128
IN_COLS = 4 * FOX_WIDTH + FOX_HEADS + POOL_WIDTH
SPLITS = (FOX_WIDTH, 2 * FOX_WIDTH, 3 * FOX_WIDTH, 4 * FOX_WIDTH, 4 * FOX_WIDTH + FOX_HEADS)
RWKV_HEADS = D_MODEL // HEAD_DIM
DECAY_LORA = 64
AAA_LORA = 64
MV_LORA = 32
GATE_LORA = 160
D_FF = -(-(8 * D_MODEL) // (3 * 256)) * 256
RMS_EPS = 1e-6
GN_EPS = 64e-5
N_EVEN = (DEPTH + 1) // 2
N_ODD = DEPTH // 2

kernel_name = 'fox_pool_rwkv7_hybrid_trunk'


def _rmsnorm(x, gain):
    xf = x.astype(jnp.float32)
    y = xf * lax.rsqrt(jnp.mean(xf * xf, axis=-1, keepdims=True) + RMS_EPS)
    return (y * gain.astype(jnp.float32)).astype(x.dtype)


def _swiglu(h, w_gate, w_up, w_down):
    return (jax.nn.silu(h @ w_gate) * (h @ w_up)) @ w_down


def _token_shift(x):
    return jnp.pad(x, ((0, 0), (1, 0), (0, 0)))[:, :-1]


def _forgetting_attention(q, k, v, cum):
    b, h, s, dh = q.shape
    nb = s // Q_BLOCK
    scale = dh ** -0.5
    qb = q.reshape(b, h, nb, Q_BLOCK, dh).transpose(2, 0, 1, 3, 4)
    cb = cum.reshape(b, h, nb, Q_BLOCK).transpose(2, 0, 1, 3)
    key_pos = jnp.arange(s)

    def one_block(args):
        i, q_i, c_i = args
        q_pos = i * Q_BLOCK + jnp.arange(Q_BLOCK)
        logits = (jnp.einsum('bhqd,bhkd->bhqk', q_i, k).astype(jnp.float32) * scale
                  + c_i[..., :, None] - cum[..., None, :])
        causal = key_pos[None, :] <= q_pos[:, None]
        p = jax.nn.softmax(jnp.where(causal, logits, -1e30), axis=-1)
        return jnp.einsum('bhqk,bhkd->bhqd', p.astype(v.dtype), v)

    out = lax.map(one_block, (jnp.arange(nb), qb, cb))
    return out.transpose(1, 2, 0, 3, 4).reshape(b, h, s, dh)


def _multiscale_causal_pool(u, pool_w, pool_scale):
    b, s, _ = u.shape
    uf = u.astype(jnp.float32).reshape(b, s, POOL_GROUPS, POOL_GROUP_DIM)
    csum = jnp.cumsum(uf, axis=1)
    pos = jnp.arange(s)
    groups = []
    for g, w in enumerate(POOL_WINDOWS):
        cg = csum[:, :, g]
        prev = jnp.pad(cg, ((0, 0), (w, 0), (0, 0)))[:, :s]
        count = jnp.minimum(pos + 1, w).astype(jnp.float32)[None, :, None]
        groups.append((cg - prev) / count - uf[:, :, g])
    pooled = jnp.stack(groups, axis=2).astype(u.dtype)
    mixed = jnp.einsum('bsgc,gcd->bsgd', pooled, pool_w)
    return mixed.reshape(b, s, POOL_WIDTH) * pool_scale


def _fox_pool_mixer(h, w_in, f_bias, q_gain, k_gain, pool_w, pool_scale, w_out):
    b, s, _ = h.shape
    proj = h @ w_in
    q, k, v, og, f_logit, u = jnp.split(proj, SPLITS, axis=-1)

    def heads(t):
        return t.reshape(b, s, FOX_HEADS, HEAD_DIM)

    q = _rmsnorm(heads(q), q_gain).transpose(0, 2, 1, 3)
    k = _rmsnorm(heads(k), k_gain).transpose(0, 2, 1, 3)
    v = heads(v).transpose(0, 2, 1, 3)
    log_f = jax.nn.log_sigmoid(f_logit.astype(jnp.float32) + f_bias.astype(jnp.float32))
    cum = jnp.cumsum(log_f, axis=1).transpose(0, 2, 1)
    attn = _forgetting_attention(q, k, v, cum).transpose(0, 2, 1, 3).reshape(b, s, FOX_WIDTH)
    attn = attn * jax.nn.sigmoid(og)
    pool = _multiscale_causal_pool(u, pool_w, pool_scale)
    return jnp.concatenate([attn, pool], axis=-1) @ w_out


def _rwkv7_step(state, inp):
    r_t, w_t, k_t, v_t, a_t, b_t = inp
    sa = jnp.einsum('bhvk,bhk->bhv', state, a_t)
    state = (state * w_t[:, :, None, :] + sa[..., None] * b_t[:, :, None, :]
             + v_t[..., None] * k_t[:, :, None, :])
    return state, jnp.einsum('bhvk,bhk->bhv', state, r_t)


def _rwkv7_time_mix(h, mu, w_r, w_k, w_v, w0, w1, w2, a0, a1, a2, g1, g2,
                    k_k, k_a, r_k, ln_w, ln_b, w_o, v_first, v_mix):
    b, s, d = h.shape
    f32 = jnp.float32
    xx = _token_shift(h) - h
    xr, xw, xk, xv, xa, xg = [h + xx * mu[i] for i in range(6)]
    r = (xr @ w_r).astype(f32)
    k = (xk @ w_k).astype(f32)
    v = (xv @ w_v).astype(f32)
    w = -jax.nn.softplus(-(w0 + jnp.tanh(xw @ w1) @ w2).astype(f32)) - 0.5
    a = jax.nn.sigmoid((a0 + (xa @ a1) @ a2).astype(f32))
    g = jax.nn.sigmoid(xg @ g1) @ g2
    if v_mix is None:
        v_first = v
    else:
        v0, v1, v2 = v_mix
        v = v + (v_first - v) * jax.nn.sigmoid((v0 + (xv @ v1) @ v2).astype(f32))

    def heads(t):
        return t.reshape(b, s, RWKV_HEADS, HEAD_DIM)

    kk = heads(k * k_k.astype(f32))
    kk = kk / jnp.maximum(jnp.sqrt(jnp.sum(kk * kk, axis=-1, keepdims=True)), 1e-12)
    k = k * (1.0 + (a - 1.0) * k_a.astype(f32))
    decay = jnp.exp(-jnp.exp(w))
    rh, kh, vh, ah = heads(r), heads(k), heads(v), heads(a)
    seq_first = lambda t: t.transpose(1, 0, 2, 3)
    xs = (seq_first(rh), seq_first(heads(decay)), seq_first(kh), seq_first(vh),
          seq_first(-kk), seq_first(kk * ah))
    state0 = jnp.zeros((b, RWKV_HEADS, HEAD_DIM, HEAD_DIM), f32)
    _, ys = lax.scan(_rwkv7_step, state0, xs)
    y = ys.transpose(1, 0, 2, 3)
    mean = jnp.mean(y, axis=-1, keepdims=True)
    var = jnp.mean(jnp.square(y - mean), axis=-1, keepdims=True)
    y = ((y - mean) * lax.rsqrt(var + GN_EPS)).reshape(b, s, d) * ln_w.astype(f32) + ln_b.astype(f32)
    bonus = jnp.sum(rh * kh * r_k.astype(f32), axis=-1, keepdims=True) * vh
    y = (y + bonus.reshape(b, s, d)).astype(h.dtype)
    return (y * g) @ w_o, v_first


def setup_inputs(seed: int = 0) -> dict:
    key = jax.random.key(seed)
    keys = jax.random.split(key, 40)
    counter = [0]
    f32 = jnp.float32

    def nk():
        counter[0] += 1
        return keys[counter[0] - 1]

    def nrm(shape, scale):
        return jax.random.normal(nk(), shape, f32) * scale

    def gain(shape):
        return 1.0 + 0.1 * jax.random.normal(nk(), shape, f32)

    D, F, ne, no = D_MODEL, D_FF, N_EVEN, N_ODD
    return {
        'x': nrm((BATCH, SEQ, D), 1.0),
        'mix_norm': gain((DEPTH, D)),
        'ffn_norm': gain((DEPTH, D)),
        'ffn_w_gate': nrm((DEPTH, D, F), D ** -0.5),
        'ffn_w_up': nrm((DEPTH, D, F), D ** -0.5),
        'ffn_w_down': nrm((DEPTH, F, D), F ** -0.5),
        'hy_w_in': nrm((ne, D, IN_COLS), D ** -0.5),
        'hy_f_bias': 2.0 + 0.5 * jax.random.normal(nk(), (ne, FOX_HEADS), f32),
        'hy_q_gain': gain((ne, HEAD_DIM)),
        'hy_k_gain': gain((ne, HEAD_DIM)),
        'hy_pool_w': nrm((ne, POOL_GROUPS, POOL_GROUP_DIM, POOL_GROUP_DIM), POOL_GROUP_DIM ** -0.5),
        'hy_pool_scale': gain((ne, POOL_WIDTH)),
        'hy_w_out': nrm((ne, D, D), D ** -0.5),
        'rw_mu': jax.random.uniform(nk(), (no, 6, D), f32),
        'rw_w_r': nrm((no, D, D), D ** -0.5),
        'rw_w_k': nrm((no, D, D), D ** -0.5),
        'rw_w_v': nrm((no, D, D), D ** -0.5),
        'rw_w0': nrm((no, D), 0.5),
        'rw_w1': nrm((no, D, DECAY_LORA), D ** -0.5),
        'rw_w2': nrm((no, DECAY_LORA, D), 0.5 * DECAY_LORA ** -0.5),
        'rw_a0': nrm((no, D), 0.5),
        'rw_a1': nrm((no, D, AAA_LORA), D ** -0.5),
        'rw_a2': nrm((no, AAA_LORA, D), 0.5 * AAA_LORA ** -0.5),
        'rw_g1': nrm((no, D, GATE_LORA), D ** -0.5),
        'rw_g2': nrm((no, GATE_LORA, D), GATE_LORA ** -0.5),
        'rw_k_k': gain((no, D)),
        'rw_k_a': gain((no, D)),
        'rw_r_k': nrm((no, RWKV_HEADS, HEAD_DIM), 0.1),
        'rw_ln_w': gain((no, D)),
        'rw_ln_b': nrm((no, D), 0.02),
        'rw_w_o': nrm((no, D, D), D ** -0.5),
        'rw_v0': nrm((max(no - 1, 0), D), 0.5),
        'rw_v1': nrm((max(no - 1, 0), D, MV_LORA), D ** -0.5),
        'rw_v2': nrm((max(no - 1, 0), MV_LORA, D), 0.5 * MV_LORA ** -0.5),
    }


def reference(x, mix_norm, ffn_norm, ffn_w_gate, ffn_w_up, ffn_w_down,
              hy_w_in, hy_f_bias, hy_q_gain, hy_k_gain, hy_pool_w, hy_pool_scale, hy_w_out,
              rw_mu, rw_w_r, rw_w_k, rw_w_v, rw_w0, rw_w1, rw_w2, rw_a0, rw_a1, rw_a2,
              rw_g1, rw_g2, rw_k_k, rw_k_a, rw_r_k, rw_ln_w, rw_ln_b, rw_w_o,
              rw_v0, rw_v1, rw_v2):
    v_first = None
    for layer in range(DEPTH):
        h = _rmsnorm(x, mix_norm[layer])
        if layer % 2 == 0:
            e = layer // 2
            y = _fox_pool_mixer(h, hy_w_in[e], hy_f_bias[e], hy_q_gain[e], hy_k_gain[e],
                                hy_pool_w[e], hy_pool_scale[e], hy_w_out[e])
        else:
            o = layer // 2
            v_mix = None if o == 0 else (rw_v0[o - 1], rw_v1[o - 1], rw_v2[o - 1])
            y, v_first = _rwkv7_time_mix(h, rw_mu[o], rw_w_r[o], rw_w_k[o], rw_w_v[o],
                                         rw_w0[o], rw_w1[o], rw_w2[o], rw_a0[o], rw_a1[o], rw_a2[o],
                                         rw_g1[o], rw_g2[o], rw_k_k[o], rw_k_a[o], rw_r_k[o],
                                         rw_ln_w[o], rw_ln_b[o], rw_w_o[o], v_first, v_mix)
        x = x + y
        x = x + _swiglu(_rmsnorm(x, ffn_norm[layer]), ffn_w_gate[layer], ffn_w_up[layer], ffn_w_down[layer])
    return x
```

```cpp
#include <hip/hip_runtime.h>
#include <hip/hip_cooperative_groups.h>
#include <cstdint>
#include <cstdio>
namespace cg = cooperative_groups;
#ifndef MK_CUT
#define MK_CUT 32
#endif
#ifndef MK_DOUBLE
#define MK_DOUBLE 0
#endif
#ifndef MK_SCAN2
#define MK_SCAN2 1
#endif
#ifndef MK_SC2P
#define MK_SC2P 0
#endif
#ifndef MK_BAR2
#define MK_BAR2 0
#endif
#ifndef MK_SPLIT
#define MK_SPLIT 0
#endif
#if MK_CUT < 32
namespace nv {
constexpr int D = 1024, S = 4096, NB = 8, F = 2816, INC = 2568;

__device__ __forceinline__ float softplusf(float x) { return fmaxf(x, 0.f) + log1pf(expf(-fabsf(x))); }
__device__ __forceinline__ float sigmoidf(float x) { return 1.f / (1.f + expf(-x)); }

__global__ __launch_bounds__(256) void rmsnorm(const float* __restrict__ x, const float* __restrict__ gain, float* __restrict__ out) {
    __shared__ float red[4];
    const size_t row = blockIdx.x;
    const float4 v = *(const float4*)(x + row * D + threadIdx.x * 4);
    float s = v.x * v.x + v.y * v.y + v.z * v.z + v.w * v.w;
    for (int o = 32; o > 0; o >>= 1) s += __shfl_xor(s, o);
    if ((threadIdx.x & 63) == 0) red[threadIdx.x >> 6] = s;
    __syncthreads();
    s = red[0] + red[1] + red[2] + red[3];
    const float r = rsqrtf(s * (1.f / D) + 1e-6f);
    const float4 g = *(const float4*)(gain + threadIdx.x * 4);
    float4 o4; o4.x = v.x * r * g.x; o4.y = v.y * r * g.y; o4.z = v.z * r * g.z; o4.w = v.w * r * g.w;
    *(float4*)(out + row * D + threadIdx.x * 4) = o4;
}

__global__ __launch_bounds__(256) void gemm(const float* __restrict__ A, int lda, const float* __restrict__ B, int ldb,
                                            float* __restrict__ C, int ldc, int M, int N, int K, int accum,
                                            const float* __restrict__ mu) {
    __shared__ float sA[16][65];
    __shared__ float sB[16][64];
    const int tx = threadIdx.x & 15, ty = threadIdx.x >> 4;
    const int m0 = blockIdx.y * 64, n0 = blockIdx.x * 64;
    float c[4][4];
#pragma unroll
    for (int i = 0; i < 4; ++i)
#pragma unroll
        for (int j = 0; j < 4; ++j) c[i][j] = 0.f;
    for (int k0 = 0; k0 < K; k0 += 16) {
        for (int i = threadIdx.x; i < 1024; i += 256) {
            const int m = i >> 4, k = i & 15; const int row = m0 + m;
            float v = A[(size_t)row * lda + k0 + k];
            if (mu) { const float p = row > 0 ? A[(size_t)(row - 1) * lda + k0 + k] : 0.f; v = v + (p - v) * mu[k0 + k]; }
            sA[k][m] = v;
        }
        for (int i = threadIdx.x; i < 1024; i += 256) {
            const int k = i >> 6, n = i & 63;
            sB[k][n] = (n0 + n < N) ? B[(size_t)(k0 + k) * ldb + n0 + n] : 0.f;
        }
        __syncthreads();
#pragma unroll
        for (int k = 0; k < 16; ++k) {
            float a[4], b[4];
#pragma unroll
            for (int i = 0; i < 4; ++i) { a[i] = sA[k][ty * 4 + i]; b[i] = sB[k][tx * 4 + i]; }
#pragma unroll
            for (int i = 0; i < 4; ++i)
#pragma unroll
                for (int j = 0; j < 4; ++j) c[i][j] += a[i] * b[j];
        }
        __syncthreads();
    }
#pragma unroll
    for (int i = 0; i < 4; ++i)
#pragma unroll
        for (int j = 0; j < 4; ++j) {
            const int n = n0 + tx * 4 + j; const int m = m0 + ty * 4 + i;
            if (n < N) { float* p = C + (size_t)m * ldc + n; *p = accum ? (*p + c[i][j]) : c[i][j]; }
        }
}

__global__ void qknorm(float* __restrict__ P, const float* __restrict__ qg, const float* __restrict__ kg) {
    const int idx = blockIdx.x * blockDim.x + threadIdx.x; if (idx >= S * 16) return;
    const int t = idx >> 4, j = idx & 15;
    float* p = P + (size_t)t * INC + j * 64; const float* g = j < 8 ? qg : kg;
    float s = 0.f; for (int d = 0; d < 64; ++d) s += p[d] * p[d];
    const float r = rsqrtf(s * (1.f / 64.f) + 1e-6f);
    for (int d = 0; d < 64; ++d) p[d] = p[d] * r * g[d];
}
__global__ void cumk(const float* __restrict__ P, const float* __restrict__ fb, float* __restrict__ cum) {
    const int h = threadIdx.x; if (h >= 8) return;
    float c = 0.f;
    for (int t = 0; t < S; ++t) { const float z = P[(size_t)t * INC + 2048 + h] + fb[h]; c += -softplusf(-z); cum[h * S + t] = c; }
}
__global__ __launch_bounds__(64) void attn(const float* __restrict__ P, const float* __restrict__ cum, float* __restrict__ cat) {
    __shared__ float Ks[64][64];
    __shared__ float Vs[64][64];
    __shared__ float Cs[64];
    const int h = blockIdx.y, qb = blockIdx.x, tid = threadIdx.x, t = qb * 64 + tid;
    float q[64], o[64];
#pragma unroll
    for (int d = 0; d < 64; ++d) { q[d] = P[(size_t)t * INC + h * 64 + d] * 0.125f; o[d] = 0.f; }
    const float ct = cum[h * S + t];
    float m = -1e30f, l = 0.f;
    for (int kt = 0; kt <= qb; ++kt) {
        __syncthreads();
        for (int r = 0; r < 64; ++r) {
            Ks[r][tid] = P[(size_t)(kt * 64 + r) * INC + 512 + h * 64 + tid];
            Vs[r][tid] = P[(size_t)(kt * 64 + r) * INC + 1024 + h * 64 + tid];
        }
        Cs[tid] = cum[h * S + kt * 64 + tid];
        __syncthreads();
        for (int j = 0; j < 64; ++j) {
            const int s = kt * 64 + j;
            if (s <= t) {
                float dot = 0.f;
#pragma unroll
                for (int d = 0; d < 64; ++d) dot += q[d] * Ks[j][d];
                const float lg = dot + ct - Cs[j];
                const float mn = fmaxf(m, lg); const float corr = expf(m - mn); const float p = expf(lg - mn);
                l = l * corr + p; m = mn;
#pragma unroll
                for (int d = 0; d < 64; ++d) o[d] = o[d] * corr + p * Vs[j][d];
            }
        }
    }
    const float inv = 1.f / l;
#pragma unroll
    for (int d = 0; d < 64; ++d) {
        const float og = P[(size_t)t * INC + 1536 + h * 64 + d];
        cat[(size_t)t * D + h * 64 + d] = o[d] * inv * sigmoidf(og);
    }
}
__global__ void pool(const float* __restrict__ P, float* __restrict__ tmp) {
    const int idx = blockIdx.x * blockDim.x + threadIdx.x; if (idx >= S * 512) return;
    const int t = idx >> 9, c = idx & 511, g = c >> 7; const int w = 2 << g;
    const int cnt = min(t + 1, w); float s = 0.f;
    for (int j = 0; j < cnt; ++j) s += P[(size_t)(t - j) * INC + 2056 + c];
    tmp[idx] = s / (float)cnt - P[(size_t)t * INC + 2056 + c];
}
__global__ void scale_cols(float* __restrict__ cat, const float* __restrict__ sc) {
    const int idx = blockIdx.x * blockDim.x + threadIdx.x; if (idx >= S * 512) return;
    const int t = idx >> 9, c = idx & 511; cat[(size_t)t * D + 512 + c] *= sc[c];
}
__global__ void swiglu(float* __restrict__ G, const float* __restrict__ U, int n) {
    const int idx = blockIdx.x * blockDim.x + threadIdx.x; if (idx >= n) return;
    const float g = G[idx]; G[idx] = g * sigmoidf(g) * U[idx];
}
__global__ void act_tanh(float* __restrict__ p, int n) { const int i = blockIdx.x * blockDim.x + threadIdx.x; if (i < n) p[i] = tanhf(p[i]); }
__global__ void act_sig(float* __restrict__ p, int n) { const int i = blockIdx.x * blockDim.x + threadIdx.x; if (i < n) p[i] = sigmoidf(p[i]); }
__global__ void add_bias_cols(float* __restrict__ p, const float* __restrict__ b, int n) {
    const int i = blockIdx.x * blockDim.x + threadIdx.x; if (i < n) p[i] += b[i & 1023];
}
__global__ void vmix(float* __restrict__ v, const float* __restrict__ vf, const float* __restrict__ gate, int n) {
    const int i = blockIdx.x * blockDim.x + threadIdx.x; if (i < n) { const float x = v[i]; v[i] = x + (vf[i] - x) * sigmoidf(gate[i]); }
}
__global__ void copyk(float* __restrict__ d, const float* __restrict__ s, int n) { const int i = blockIdx.x * blockDim.x + threadIdx.x; if (i < n) d[i] = s[i]; }
__global__ void rwkv_prep(float* __restrict__ k, float* __restrict__ w, float* __restrict__ a, float* __restrict__ aa,
                          const float* __restrict__ k_k, const float* __restrict__ k_a) {
    const int idx = blockIdx.x * blockDim.x + threadIdx.x; if (idx >= S * 16) return;
    const int t = idx >> 4, h = idx & 15; const size_t o = (size_t)t * D + h * 64;
    float s = 0.f;
    for (int d = 0; d < 64; ++d) { const float x = k[o + d] * k_k[h * 64 + d]; s += x * x; }
    const float inv = 1.f / fmaxf(sqrtf(s), 1e-12f);
    for (int d = 0; d < 64; ++d) {
        const float kv = k[o + d]; const float kk = kv * k_k[h * 64 + d] * inv; const float av = sigmoidf(a[o + d]);
        const float wl = -softplusf(-w[o + d]) - 0.5f;
        w[o + d] = expf(-expf(wl));
        k[o + d] = kv * (1.f + (av - 1.f) * k_a[h * 64 + d]);
        a[o + d] = kk * av; aa[o + d] = -kk;
    }
}
__global__ __launch_bounds__(64) void scan(const float* __restrict__ r, const float* __restrict__ w, const float* __restrict__ k, const float* __restrict__ v,
                                           const float* __restrict__ aa, const float* __restrict__ bb, float* __restrict__ y) {
    __shared__ float sr[64], sw[64], sk[64], sa[64], sb[64];
    const int h = blockIdx.x, row = threadIdx.x;
    float st[64];
#pragma unroll
    for (int i = 0; i < 64; ++i) st[i] = 0.f;
    for (int t = 0; t < S; ++t) {
        const size_t o = (size_t)t * D + h * 64;
        __syncthreads();
        sr[row] = r[o + row]; sw[row] = w[o + row]; sk[row] = k[o + row]; sa[row] = aa[o + row]; sb[row] = bb[o + row];
        const float vv = v[o + row];
        __syncthreads();
        float dot = 0.f;
#pragma unroll
        for (int i = 0; i < 64; ++i) dot += st[i] * sa[i];
        float yo = 0.f;
#pragma unroll
        for (int i = 0; i < 64; ++i) { st[i] = st[i] * sw[i] + dot * sb[i] + vv * sk[i]; yo += st[i] * sr[i]; }
        y[o + row] = yo;
    }
}
__global__ void rwkv_post(float* __restrict__ y, const float* __restrict__ r, const float* __restrict__ k, const float* __restrict__ v, const float* __restrict__ g,
                          const float* __restrict__ r_k, const float* __restrict__ ln_w, const float* __restrict__ ln_b) {
    const int idx = blockIdx.x * blockDim.x + threadIdx.x; if (idx >= S * 16) return;
    const int t = idx >> 4, h = idx & 15; const size_t o = (size_t)t * D + h * 64;
    float mean = 0.f; for (int d = 0; d < 64; ++d) mean += y[o + d]; mean *= (1.f / 64.f);
    float var = 0.f; for (int d = 0; d < 64; ++d) { const float x = y[o + d] - mean; var += x * x; } var *= (1.f / 64.f);
    const float rs = rsqrtf(var + 64e-5f);
    float bs = 0.f; for (int d = 0; d < 64; ++d) bs += r[o + d] * k[o + d] * r_k[h * 64 + d];
    for (int d = 0; d < 64; ++d) {
        const float yn = (y[o + d] - mean) * rs * ln_w[h * 64 + d] + ln_b[h * 64 + d];
        y[o + d] = (yn + bs * v[o + d]) * g[o + d];
    }
}
static inline dim3 g1(int n) { return dim3((n + 255) / 256); }

__global__ void bf2f(const unsigned short* __restrict__ s, float* __restrict__ d, int n) { const int i = blockIdx.x * blockDim.x + threadIdx.x; if (i < n) d[i] = __uint_as_float((unsigned)s[i] << 16); }
static void run_from(void* const* d_in, float* X, unsigned char* wsb, int cut, hipStream_t stream) {
    const float* const* in = (const float* const*)d_in;
    if (cut == 0) (void)hipMemcpyAsync(X, in[0], (size_t)NB * S * D * 4, hipMemcpyDeviceToDevice, stream);
    float* ws = (float*)(wsb + ((size_t)152 << 20));
    const int start_layer = cut == 0 ? 0 : cut == 4 ? 0 : cut == 7 ? 1 : cut == 13 ? 1 : cut == 16 ? 2 : cut == 20 ? 2 : cut == 23 ? 3 : 3;
    const int start_ffn = (cut == 4 || cut == 13 || cut == 20 || cut == 29) ? 1 : 0;
    if (cut >= 13) hipLaunchKernelGGL(bf2f, dim3((NB * S * D + 255) / 256), dim3(256), 0, stream, (const unsigned short*)(wsb + ((size_t)88 << 20)), ws, NB * S * D);
    const size_t SD = (size_t)S * D;
    float* VF = ws;
    float* H = VF + NB * SD;
    float* B0 = H + SD;
    auto GEMM = [&](const float* A, int lda, const float* B, int ldb, float* C, int ldc, int M, int N, int K, int acc, const float* mu) {
        hipLaunchKernelGGL(gemm, dim3((N + 63) / 64, M / 64), dim3(256), 0, stream, A, lda, B, ldb, C, ldc, M, N, K, acc, mu);
    };
    for (int layer = start_layer; layer < 4; ++layer) {
        for (int b = 0; b < NB; ++b) {
            float* xb = X + b * SD;
            const bool do_mixer = !(layer == start_layer && start_ffn);
            if (do_mixer) hipLaunchKernelGGL(rmsnorm, dim3(S), dim3(256), 0, stream, xb, in[1] + layer * D, H);
            if (!do_mixer) {
            } else if (layer % 2 == 0) {
                const int e = layer / 2;
                float* P = B0;
                float* CAT = P + (size_t)S * INC;
                float* TMP = CAT + SD;
                float* CUM = TMP + (size_t)S * 512;
                GEMM(H, D, in[6] + (size_t)e * D * INC, INC, P, INC, S, INC, D, 0, nullptr);
                hipLaunchKernelGGL(qknorm, g1(S * 16), dim3(256), 0, stream, P, in[8] + e * 64, in[9] + e * 64);
                hipLaunchKernelGGL(cumk, dim3(1), dim3(64), 0, stream, P, in[7] + e * 8, CUM);
                hipLaunchKernelGGL(attn, dim3(S / 64, 8), dim3(64), 0, stream, P, CUM, CAT);
                hipLaunchKernelGGL(pool, g1(S * 512), dim3(256), 0, stream, P, TMP);
                for (int g = 0; g < 4; ++g)
                    GEMM(TMP + g * 128, 512, in[10] + ((size_t)e * 4 + g) * 128 * 128, 128, CAT + 512 + g * 128, D, S, 128, 128, 0, nullptr);
                hipLaunchKernelGGL(scale_cols, g1(S * 512), dim3(256), 0, stream, CAT, in[11] + e * 512);
                GEMM(CAT, D, in[12] + (size_t)e * D * D, D, xb, D, S, D, D, 1, nullptr);
            } else {
                const int o = layer / 2;
                float* R = B0; float* K_ = R + SD; float* V = K_ + SD; float* W = V + SD; float* A_ = W + SD; float* G = A_ + SD; float* AA = G + SD; float* Y = AA + SD;
                float* MW = Y + SD; float* MA = MW + (size_t)S * 64; float* MG = MA + (size_t)S * 64; float* MV = MG + (size_t)S * 160;
                const float* mu = in[13] + (size_t)o * 6 * D;
                GEMM(H, D, in[14] + (size_t)o * D * D, D, R, D, S, D, D, 0, mu + 0 * D);
                GEMM(H, D, in[15] + (size_t)o * D * D, D, K_, D, S, D, D, 0, mu + 2 * D);
                GEMM(H, D, in[16] + (size_t)o * D * D, D, V, D, S, D, D, 0, mu + 3 * D);
                GEMM(H, D, in[18] + (size_t)o * D * 64, 64, MW, 64, S, 64, D, 0, mu + 1 * D);
                hipLaunchKernelGGL(act_tanh, g1(S * 64), dim3(256), 0, stream, MW, S * 64);
                GEMM(MW, 64, in[19] + (size_t)o * 64 * D, D, W, D, S, D, 64, 0, nullptr);
                hipLaunchKernelGGL(add_bias_cols, g1(S * D), dim3(256), 0, stream, W, in[17] + o * D, S * D);
                GEMM(H, D, in[21] + (size_t)o * D * 64, 64, MA, 64, S, 64, D, 0, mu + 4 * D);
                GEMM(MA, 64, in[22] + (size_t)o * 64 * D, D, A_, D, S, D, 64, 0, nullptr);
                hipLaunchKernelGGL(add_bias_cols, g1(S * D), dim3(256), 0, stream, A_, in[20] + o * D, S * D);
                GEMM(H, D, in[23] + (size_t)o * D * 160, 160, MG, 160, S, 160, D, 0, mu + 5 * D);
                hipLaunchKernelGGL(act_sig, g1(S * 160), dim3(256), 0, stream, MG, S * 160);
                GEMM(MG, 160, in[24] + (size_t)o * 160 * D, D, G, D, S, D, 160, 0, nullptr);
                if (o == 0) {
                    hipLaunchKernelGGL(copyk, g1(S * D), dim3(256), 0, stream, VF + b * SD, V, S * D);
                } else {
                    GEMM(H, D, in[32] + (size_t)(o - 1) * D * 32, 32, MV, 32, S, 32, D, 0, mu + 3 * D);
                    GEMM(MV, 32, in[33] + (size_t)(o - 1) * 32 * D, D, Y, D, S, D, 32, 0, nullptr);
                    hipLaunchKernelGGL(add_bias_cols, g1(S * D), dim3(256), 0, stream, Y, in[31] + (o - 1) * D, S * D);
                    hipLaunchKernelGGL(vmix, g1(S * D), dim3(256), 0, stream, V, VF + b * SD, Y, S * D);
                }
                hipLaunchKernelGGL(rwkv_prep, g1(S * 16), dim3(256), 0, stream, K_, W, A_, AA, in[25] + o * D, in[26] + o * D);
                hipLaunchKernelGGL(scan, dim3(16), dim3(64), 0, stream, R, W, K_, V, AA, A_, Y);
                hipLaunchKernelGGL(rwkv_post, g1(S * 16), dim3(256), 0, stream, Y, R, K_, V, G, in[27] + o * D, in[28] + o * D, in[29] + o * D);
                GEMM(Y, D, in[30] + (size_t)o * D * D, D, xb, D, S, D, D, 1, nullptr);
            }
            float* G = B0; float* U = G + (size_t)S * F;
            hipLaunchKernelGGL(rmsnorm, dim3(S), dim3(256), 0, stream, xb, in[2] + layer * D, H);
            GEMM(H, D, in[3] + (size_t)layer * D * F, F, G, F, S, F, D, 0, nullptr);
            GEMM(H, D, in[4] + (size_t)layer * D * F, F, U, F, S, F, D, 0, nullptr);
            hipLaunchKernelGGL(swiglu, g1(S * F), dim3(256), 0, stream, G, U, S * F);
            GEMM(G, F, in[5] + (size_t)layer * F * D, D, xb, D, S, D, F, 1, nullptr);
        }
    }
}
}
#endif
namespace mk {
#define LAS __attribute__((address_space(3)))
#define GAS __attribute__((address_space(1)))
typedef unsigned short bf16_t;
typedef short bf16x8 __attribute__((ext_vector_type(8)));
typedef short s16x4 __attribute__((ext_vector_type(4)));
typedef float f32x4 __attribute__((ext_vector_type(4)));
typedef float f32x2 __attribute__((ext_vector_type(2)));
typedef float f32x16 __attribute__((ext_vector_type(16)));
typedef unsigned u32x4 __attribute__((ext_vector_type(4)));
typedef unsigned u32x2 __attribute__((ext_vector_type(2)));

constexpr int T = 32768, S = 4096, D = 1024, F = 2816, INC = 2568, NPROJ = 2560;
constexpr float LOG2E = 1.4426950408889634f;
constexpr float QSCALE = 0.125f * LOG2E;
constexpr size_t MiB = 1u << 20;
constexpr size_t WS_LF = 0, WS_BON = 1 * MiB, WS_WB = 3 * MiB, WS_HB = 23 * MiB, WS_VF = 88 * MiB, WS_BIG = 152 * MiB;
constexpr size_t WS_R = WS_BIG, WS_K = WS_BIG + 64 * MiB, WS_V = WS_BIG + 128 * MiB, WS_W = WS_BIG + 192 * MiB, WS_A = WS_BIG + 256 * MiB, WS_LM = WS_BIG + 320 * MiB;
constexpr size_t WS_CTL = WS_LM + 32 * MiB;
constexpr size_t WS_END = WS_CTL + 16384;
constexpr size_t WB_WIN = 0, WB_WOUT = 5242880;
constexpr size_t WB_WR2 = 0, WB_WR3 = 14680064, WB_WG = 17039360, WB_WO = 17563648;
constexpr size_t WB_WGU = 0, WB_WD = 11534336;
constexpr int LDS_BYTES = 147456;

typedef __bf16 b16x2_t __attribute__((ext_vector_type(2)));
__device__ __forceinline__ unsigned cvt_pk_bf16(float lo, float hi) { const f32x2 v = {lo, hi}; return __builtin_bit_cast(unsigned, __builtin_convertvector(v, b16x2_t)); }
__device__ __forceinline__ float bf_lo(unsigned u) { return __uint_as_float(u << 16); }
__device__ __forceinline__ float bf_hi(unsigned u) { return __uint_as_float(u & 0xffff0000u); }
__device__ __forceinline__ float fexp2(float x) { return __builtin_amdgcn_exp2f(x); }
__device__ __forceinline__ float frcp(float x) { return __builtin_amdgcn_rcpf(x); }
__device__ __forceinline__ float fsigmoid(float x) { return frcp(1.f + fexp2(-x * LOG2E)); }
__device__ __forceinline__ float wave_sum(float v) {
#pragma unroll
    for (int o = 1; o < 64; o <<= 1) v += __shfl_xor(v, o);
    return v;
}
template <int CTRL> __device__ __forceinline__ float dpp_f(float v) {
    return __builtin_bit_cast(float, __builtin_amdgcn_update_dpp(0, __builtin_bit_cast(int, v), CTRL, 0xF, 0xF, true));
}
__device__ __forceinline__ float reduce16(float v) {
    v += dpp_f<0xB1>(v); v += dpp_f<0x4E>(v); v += dpp_f<0x141>(v); v += dpp_f<0x140>(v);
    return v;
}
__device__ __forceinline__ const float* ldp(const LAS unsigned* PL, int i) {
    unsigned lo = __builtin_amdgcn_readfirstlane(PL[2 * i]), hi = __builtin_amdgcn_readfirstlane(PL[2 * i + 1]);
    asm volatile("" : "+s"(lo), "+s"(hi));
    return (const float*)(((unsigned long long)hi << 32) | lo);
}
__device__ __forceinline__ int lane_id() { int l = (int)__builtin_amdgcn_mbcnt_hi(~0u, __builtin_amdgcn_mbcnt_lo(~0u, 0u)); asm volatile("" : "+v"(l)); return l; }
#define SC_MUL(d, a, b) asm("v_mul_f32 %0, %1, %2" : "=v"(d) : "v"(a), "v"(b))
#define SC_FMAC(d, a, b) asm("v_fmac_f32 %0, %1, %2" : "+v"(d) : "v"(a), "v"(b))
__device__ __forceinline__ f32x4 unpack4(const u32x2 w) { return (f32x4){bf_lo(w.x), bf_hi(w.x), bf_lo(w.y), bf_hi(w.y)}; }
typedef _Float16 f16x4 __attribute__((ext_vector_type(4)));
typedef _Float16 f16x8 __attribute__((ext_vector_type(8)));
__device__ __forceinline__ void unpack8h(const u32x4 w, f32x4& a, f32x4& b) { const f16x8 hv = __builtin_bit_cast(f16x8, w);
    a = __builtin_convertvector(__builtin_shufflevector(hv, hv, 0, 1, 2, 3), f32x4); b = __builtin_convertvector(__builtin_shufflevector(hv, hv, 4, 5, 6, 7), f32x4); }
__device__ __forceinline__ u32x4 pack8h(const f32x4 a, const f32x4 b) { const f16x4 x = __builtin_convertvector(a, f16x4), y = __builtin_convertvector(b, f16x4);
    return __builtin_bit_cast(u32x4, __builtin_shufflevector(x, y, 0, 1, 2, 3, 4, 5, 6, 7)); }
__device__ __forceinline__ f32x4 unpack4h(const u32x2 w) { return __builtin_convertvector(__builtin_bit_cast(f16x4, w), f32x4); }
#define LDS_WAIT() asm volatile("s_waitcnt lgkmcnt(0)" ::: "memory")

constexpr int BM = 256, BK = 64, HALF = 128, HTB = HALF * BK * 2, STAGE_BYTES = 8 * HTB, NXCD = 8, WGM = 8;
__host__ __device__ __forceinline__ int lds_byte(int r, int c) { const int st = (r >> 4) * 2 + (c >> 5), rr = r & 15, cc = c & 31, ob = rr * 64 + cc * 2; return st * 1024 + (ob ^ (((ob >> 9) & 1) << 5)); }
__host__ __device__ __forceinline__ void stage_rc(int b, int& R, int& C) { const int st = b / 1024, sb = b % 1024, swz = sb ^ (((sb >> 9) & 1) << 5); R = (st >> 1) * 16 + swz / 64; C = (st & 1) * 32 + (swz % 64) / 2; }
__host__ __device__ __forceinline__ int perm32(int rho) { const int n = rho >> 4, i = rho & 15; return 8 * (i >> 2) + 4 * n + (i & 3); }
struct Unit { int pm, pn; };
struct Gemm { const bf16_t* A; const bf16_t* Bt; int M, N, K, lda, ldb, apad, ksplit, off_lo, off_hi; int apn_shift; size_t apn_stride; };
struct StaticOrder {
    int nM, nN, nwg, G, c;
    __device__ void init(int M, int N, int G_, int c_) { nM = M / BM; nN = N / BM; nwg = nM * nN; G = G_; c = c_; }
    __device__ bool next(int i, Unit& u) const {
        const long L = (long)i * G + c; if (L >= nwg) return false;
        int wgid = (int)L; { const int q = nwg / NXCD, r = nwg % NXCD, xcd = wgid % NXCD, off = wgid / NXCD; wgid = (xcd < r ? xcd * (q + 1) : r * (q + 1) + (xcd - r) * q) + off; }
        const int nig = WGM * nN, gid = wgid / nig, fm = gid * WGM, gsz = (nM - fm) < WGM ? (nM - fm) : WGM;
        u.pm = fm + ((wgid % nig) % gsz); u.pn = (wgid % nig) / gsz; return true;
    }
};
typedef f32x4 Acc[2][2][4][2];

template <class Epi>
__device__ __forceinline__ void gemm_phase(LAS unsigned char* lds, const int wid, const Gemm g, const Epi& E) {
    const int lane = lane_id(), tid = wid * 64 + lane, wr = wid >> 2, wc = wid & 3, fr = lane & 15, fq = lane >> 4;
    const int nt = g.K / BK;
    StaticOrder S; S.init(g.M, g.N, (int)gridDim.x, (int)blockIdx.x);
    unsigned voffA[2], voffB[2];
#pragma unroll
    for (int i = 0; i < 2; ++i) { int R, C; stage_rc(tid * 16 + i * 8192, R, C); const int Rb = Epi::PERM ? ((R & ~31) + perm32(R & 31)) : R;
        voffA[i] = (unsigned)(R * g.lda + C) * 2u; voffB[i] = (unsigned)(Rb * g.ldb + C) * 2u; }
    const size_t kstep = (size_t)(BK * 2);
    const size_t hstepA = (size_t)HALF * g.lda * 2, hstepB = (size_t)HALF * g.ldb * 2;
    const unsigned ldsw = (unsigned)wid * 1024u;
    const int aoff = lds_byte(wr * 64 + fr, fq * 8), boff = lds_byte(wc * 32 + fr, fq * 8);
#define PG8_SA(b, h) (((b) * 2 + (h)) * HTB)
#define PG8_SB(b, h) ((4 + (b) * 2 + (h)) * HTB)
#define PG8_STAGE(bufoff, gbase, voff) do { const char* _gb = (const char*)(gbase); asm volatile("" : "+s"(_gb));     \
        _Pragma("unroll") for (int _i = 0; _i < 2; ++_i) \
        __builtin_amdgcn_global_load_lds((const unsigned*)(_gb + (voff)[_i]), (LAS unsigned*)(lds + (bufoff) + ldsw + _i * 8192), 16, 0, 0); } while (0)
#define PG8_LDA(dst, b, h) do { _Pragma("unroll") for (int m = 0; m < 4; ++m) _Pragma("unroll") for (int k = 0; k < 2; ++k) dst[m][k] = *(const LAS bf16x8*)(lds + PG8_SA(b, h) + aoff + m * 2048 + k * 1024); } while (0)
#define PG8_LDB(dst, b, h) do { _Pragma("unroll") for (int n = 0; n < 2; ++n) _Pragma("unroll") for (int k = 0; k < 2; ++k) dst[n][k] = *(const LAS bf16x8*)(lds + PG8_SB(b, h) + boff + n * 2048 + k * 1024); } while (0)
#define PG8_MMA(ai, bj, At, Bt) do { __builtin_amdgcn_s_setprio(1); _Pragma("unroll") for (int m = 0; m < 4; ++m) _Pragma("unroll") for (int n = 0; n < 2; ++n) _Pragma("unroll") for (int k = 0; k < 2; ++k) \
        acc[ai][bj][m][n] = __builtin_amdgcn_mfma_f32_16x16x32_bf16(Bt[n][k], At[m][k], acc[ai][bj][m][n], 0, 0, 0); __builtin_amdgcn_s_setprio(0); } while (0)
#define PG8_WAIT_V(n) asm volatile("s_waitcnt vmcnt(" #n ")" ::: "memory")
#define PG8_WAIT_L(n) asm volatile("s_waitcnt lgkmcnt(" #n ")" ::: "memory")
#define PG8_BAR __builtin_amdgcn_s_barrier()
#define PG8_SCHED __builtin_amdgcn_sched_barrier(0)
#define PG8_AP(base, kt) ((base) + (size_t)(kt) * kstep + (long)(((kt) < g.ksplit) ? g.off_lo : g.off_hi))
#define PG8_BP(base, kt) ((base) + (size_t)(kt) * kstep)
#define PG8_UA(u) ((const char*)g.A + ((size_t)(u).pm * BM + (size_t)((u).pm >> 4) * g.apad) * g.lda * 2 + (size_t)((u).pn >> g.apn_shift) * g.apn_stride)
#define PG8_UB(u) ((const char*)g.Bt + (size_t)(u).pn * BM * g.ldb * 2)
    Unit cur, nxt; int ui = 0;
    if (!S.next(0, cur)) return;
    Acc acc;
#pragma unroll
    for (int a = 0; a < 2; ++a)
#pragma unroll
        for (int b = 0; b < 2; ++b)
#pragma unroll
            for (int m = 0; m < 4; ++m)
#pragma unroll
                for (int n = 0; n < 2; ++n) acc[a][b][m][n] = (f32x4){0.f, 0.f, 0.f, 0.f};
    bf16x8 At[4][2], B0[2][2], B1[2][2];
    const char* cA = PG8_UA(cur); const char* cB = PG8_UB(cur);
    PG8_STAGE(PG8_SB(0, 0), PG8_BP(cB, 0), voffB); PG8_STAGE(PG8_SB(0, 1), PG8_BP(cB, 0) + hstepB, voffB); PG8_STAGE(PG8_SA(0, 0), PG8_AP(cA, 0), voffA); PG8_STAGE(PG8_SA(0, 1), PG8_AP(cA, 0) + hstepA, voffA);
    if (wr == 1) PG8_BAR;
    PG8_WAIT_V(2); PG8_BAR;
    PG8_STAGE(PG8_SB(1, 0), PG8_BP(cB, 1), voffB); PG8_STAGE(PG8_SA(1, 0), PG8_AP(cA, 1), voffA); PG8_STAGE(PG8_SB(1, 1), PG8_BP(cB, 1) + hstepB, voffB);
    PG8_WAIT_V(6); PG8_BAR;
    for (;;) {
        const bool has_next = S.next(ui + 1, nxt);
        const char* nA = has_next ? PG8_UA(nxt) : cA; const char* nB = has_next ? PG8_UB(nxt) : cB;
        for (int t = 0; t < nt; t += 2) {
            const bool last = (t == nt - 2);
            const char* a1 = PG8_AP(cA, t + 1);
            const char* a2 = last ? PG8_AP(nA, 0) : PG8_AP(cA, t + 2); const char* b2 = last ? PG8_BP(nB, 0) : PG8_BP(cB, t + 2);
            const char* a3 = last ? PG8_AP(nA, 1) : PG8_AP(cA, t + 3); const char* b3 = last ? PG8_BP(nB, 1) : PG8_BP(cB, t + 3);
            PG8_LDB(B0, 0, 0); PG8_LDB(B1, 0, 1); PG8_SCHED; PG8_LDA(At, 0, 0); PG8_STAGE(PG8_SA(1, 1), a1 + hstepA, voffA);
            PG8_WAIT_V(8); PG8_WAIT_L(0); PG8_BAR; PG8_MMA(0, 0, At, B0); PG8_MMA(0, 1, At, B1); PG8_BAR; PG8_SCHED;
            PG8_LDA(At, 0, 1); PG8_STAGE(PG8_SB(0, 0), b2, voffB); PG8_STAGE(PG8_SB(0, 1), b2 + hstepB, voffB); PG8_STAGE(PG8_SA(0, 0), a2, voffA);
            PG8_WAIT_V(8); PG8_WAIT_L(0); PG8_BAR; PG8_MMA(1, 0, At, B0); PG8_MMA(1, 1, At, B1); PG8_BAR; PG8_SCHED;
            PG8_LDB(B0, 1, 0); PG8_LDB(B1, 1, 1); PG8_SCHED; PG8_LDA(At, 1, 0); PG8_STAGE(PG8_SA(0, 1), a2 + hstepA, voffA);
            PG8_WAIT_V(8); PG8_WAIT_L(0); PG8_BAR; PG8_MMA(0, 0, At, B0); PG8_MMA(0, 1, At, B1); PG8_BAR; PG8_SCHED;
            PG8_LDA(At, 1, 1); PG8_STAGE(PG8_SB(1, 0), b3, voffB); PG8_STAGE(PG8_SB(1, 1), b3 + hstepB, voffB); PG8_STAGE(PG8_SA(1, 0), a3, voffA);
            PG8_WAIT_V(8); PG8_WAIT_L(0); PG8_BAR; PG8_MMA(1, 0, At, B0); PG8_MMA(1, 1, At, B1); PG8_BAR; PG8_SCHED;
        }
        if (wr == 0) PG8_BAR;
        { int le = lane; asm volatile("" : "+v"(le)); E(acc, cur, wr, wc, le & 15, le >> 4); }
        if (!has_next) break;
#pragma unroll
        for (int a = 0; a < 2; ++a)
#pragma unroll
            for (int b = 0; b < 2; ++b)
#pragma unroll
                for (int m = 0; m < 4; ++m)
#pragma unroll
                    for (int n = 0; n < 2; ++n) acc[a][b][m][n] = (f32x4){0.f, 0.f, 0.f, 0.f};
        cur = nxt; cA = nA; cB = nB; ++ui;
        if (wr == 1) PG8_BAR;
    }
    PG8_WAIT_V(0);
    PG8_BAR;
}
__device__ __forceinline__ u32x4 pack8(const f32x4 a, const f32x4 b) {
    u32x4 w; w.x = cvt_pk_bf16(a[0], a[1]); w.y = cvt_pk_bf16(a[2], a[3]); w.z = cvt_pk_bf16(b[0], b[1]); w.w = cvt_pk_bf16(b[2], b[3]); return w;
}
__device__ __forceinline__ void unpack8(const u32x4 w, f32x4& a, f32x4& b) {
    a[0] = bf_lo(w.x); a[1] = bf_hi(w.x); a[2] = bf_lo(w.y); a[3] = bf_hi(w.y); b[0] = bf_lo(w.z); b[1] = bf_hi(w.z); b[2] = bf_lo(w.w); b[3] = bf_hi(w.w);
}
struct EpiHybIn {
    static constexpr bool PERM = true;
    bf16_t* P; const float* qg; const float* kg;
    __device__ __forceinline__ void operator()(const Acc& acc, const Unit& u, int wr, int wc, int fr, int fq) const {
        const int kind = u.pn >> 1, half = u.pn & 1;
        const int row0 = u.pm * BM + wr * 64 + fr;
        if (kind < 2) {
            const float* gn = kind == 0 ? qg : kg; const float sc = kind == 0 ? QSCALE : 1.f;
            f32x4 gv[2][2];
#pragma unroll
            for (int bj = 0; bj < 2; ++bj)
#pragma unroll
                for (int n = 0; n < 2; ++n) gv[bj][n] = *(const GAS f32x4*)(gn + 32 * bj + 8 * fq + 4 * n);
            const int colb = kind * 512 + half * 256 + wc * 64 + 8 * fq;
#pragma unroll
            for (int ai = 0; ai < 2; ++ai)
#pragma unroll
                for (int m = 0; m < 4; ++m) {
                    float ss = 0.f;
#pragma unroll
                    for (int bj = 0; bj < 2; ++bj)
#pragma unroll
                        for (int n = 0; n < 2; ++n) { const f32x4 x = acc[ai][bj][m][n]; ss += (x[0] * x[0] + x[1] * x[1]) + (x[2] * x[2] + x[3] * x[3]); }
                    ss += __shfl_xor(ss, 16); ss += __shfl_xor(ss, 32);
                    const float rs = rsqrtf(ss * (1.f / 64.f) + 1e-6f) * sc;
                    bf16_t* rowp = P + (size_t)(row0 + ai * HALF + m * 16) * NPROJ + colb;
#pragma unroll
                    for (int bj = 0; bj < 2; ++bj) *(GAS u32x4*)(rowp + 32 * bj) = pack8(acc[ai][bj][m][0] * rs * gv[bj][0], acc[ai][bj][m][1] * rs * gv[bj][1]);
                }
        } else {
            const int colb = kind * 512 + half * 256 + wc * 32 + 8 * fq;
#pragma unroll
            for (int ai = 0; ai < 2; ++ai)
#pragma unroll
                for (int m = 0; m < 4; ++m) {
                    bf16_t* rowp = P + (size_t)(row0 + ai * HALF + m * 16) * NPROJ + colb;
#pragma unroll
                    for (int bj = 0; bj < 2; ++bj) {
                        f32x4 v0 = acc[ai][bj][m][0], v1 = acc[ai][bj][m][1];
                        if (kind == 3) {
#pragma unroll
                            for (int j = 0; j < 4; ++j) { v0[j] = fsigmoid(v0[j]); v1[j] = fsigmoid(v1[j]); }
                        }
                        *(GAS u32x4*)(rowp + 128 * bj) = pack8(v0, v1);
                    }
                }
        }
    }
};
template <bool BASE_F32, bool OUT_F32>
struct EpiRes {
    static constexpr bool PERM = true;
    const void* base; void* out;
    __device__ __forceinline__ void operator()(const Acc& acc, const Unit& u, int wr, int wc, int fr, int fq) const {
        const int row0 = u.pm * BM + wr * 64 + fr, col0 = u.pn * BM + wc * 32 + 8 * fq;
#pragma unroll
        for (int ai = 0; ai < 2; ++ai)
#pragma unroll
            for (int m = 0; m < 4; ++m) {
                const size_t off = (size_t)(row0 + ai * HALF + m * 16) * D + col0;
#pragma unroll
                for (int bj = 0; bj < 2; ++bj) {
                    const size_t p = off + bj * HALF;
                    f32x4 b0, b1;
                    if (BASE_F32) { b0 = *(const GAS f32x4*)((const float*)base + p); b1 = *(const GAS f32x4*)((const float*)base + p + 4); }
                    else unpack8h(*(const GAS u32x4*)((const bf16_t*)base + p), b0, b1);
                    b0 += acc[ai][bj][m][0]; b1 += acc[ai][bj][m][1];
                    if (OUT_F32) { *(GAS f32x4*)((float*)out + p) = b0; *(GAS f32x4*)((float*)out + p + 4) = b1; }
                    else *(GAS u32x4*)((bf16_t*)out + p) = pack8h(b0, b1);
                }
                asm volatile("" ::: "memory");
            }
    }
};
struct EpiSwiglu {
    static constexpr bool PERM = true;
    bf16_t* ACT;
    __device__ __forceinline__ void operator()(const Acc& acc, const Unit& u, int wr, int wc, int fr, int fq) const {
        const int row0 = u.pm * BM + wr * 64 + fr, col0 = u.pn * HALF + wc * 32 + 8 * fq;
#pragma unroll
        for (int ai = 0; ai < 2; ++ai)
#pragma unroll
            for (int m = 0; m < 4; ++m) {
                f32x4 o[2];
#pragma unroll
                for (int n = 0; n < 2; ++n)
#pragma unroll
                    for (int j = 0; j < 4; ++j) { const float gx = acc[ai][0][m][n][j]; o[n][j] = gx * fsigmoid(gx) * acc[ai][1][m][n][j]; }
                *(GAS u32x4*)(ACT + (size_t)(row0 + ai * HALF + m * 16) * F + col0) = pack8(o[0], o[1]);
            }
    }
};
struct EpiRwkvIn {
    static constexpr bool PERM = true;
    bf16_t* R; long koff, voff; bf16_t* LM; int pn_off;
    __device__ __forceinline__ void operator()(const Acc& acc, const Unit& u, int wr, int wc, int fr, int fq) const {
        const int lpn = u.pn + pn_off, t4 = lpn >> 2;
        const int row0 = u.pm * BM + wr * 64 + fr;
        if (t4 < 3) {
            bf16_t* dst = R + (t4 == 0 ? 0L : (t4 == 1 ? koff : voff));
            const int colb = (lpn & 3) * 256 + wc * 32 + 8 * fq;
#pragma unroll
            for (int ai = 0; ai < 2; ++ai)
#pragma unroll
                for (int m = 0; m < 4; ++m) {
                    bf16_t* rowp = dst + (size_t)(row0 + ai * HALF + m * 16) * D + colb;
#pragma unroll
                    for (int bj = 0; bj < 2; ++bj) *(GAS u32x4*)(rowp + 128 * bj) = pack8(acc[ai][bj][m][0], acc[ai][bj][m][1]);
                }
        } else {
            const int colb = (lpn - 12) * 256 + wc * 32 + 8 * fq;
#pragma unroll
            for (int ai = 0; ai < 2; ++ai)
#pragma unroll
                for (int m = 0; m < 4; ++m) {
                    bf16_t* rowp = LM + (size_t)(row0 + ai * HALF + m * 16) * 512 + colb;
#pragma unroll
                    for (int bj = 0; bj < 2; ++bj) {
                        const int c = colb + 128 * bj;
                        f32x4 v0 = acc[ai][bj][m][0], v1 = acc[ai][bj][m][1];
                        if (c < 64) {
#pragma unroll
                            for (int j = 0; j < 4; ++j) { v0[j] = 2.f * fsigmoid(2.f * v0[j]) - 1.f; v1[j] = 2.f * fsigmoid(2.f * v1[j]) - 1.f; }
                        } else if (c >= 128 && c < 288) {
#pragma unroll
                            for (int j = 0; j < 4; ++j) { v0[j] = fsigmoid(v0[j]); v1[j] = fsigmoid(v1[j]); }
                        }
                        *(GAS u32x4*)(rowp + 128 * bj) = pack8(v0, v1);
                    }
                }
        }
    }
};
struct EpiLoraUp {
    static constexpr bool PERM = true;
    bf16_t* W; const bf16_t* VF; const LAS unsigned* PL; int idx;
    __device__ __forceinline__ void operator()(const Acc& acc, const Unit& u, int wr, int wc, int fr, int fq) const {
        const int t4 = u.pn >> 2;
        const int row0 = u.pm * BM + wr * 64 + fr;
        const int colb = (u.pn & 3) * 256 + wc * 32 + 8 * fq;
        const float* bias = ldp(PL, t4 == 0 ? 17 : (t4 == 1 ? 20 : 31)) + (t4 < 2 ? idx * D : 0);
        bf16_t* dst = W + (t4 == 0 ? 0L : (t4 == 1 ? (long)(32u << 20) : -(long)(32u << 20)));
        const bf16_t* V = W - (long)(32u << 20);
        const float osc = t4 == 0 ? 0.60653065971f : 1.f;
#pragma unroll
        for (int bj = 0; bj < 2; ++bj) {
            const f32x4 b0 = *(const GAS f32x4*)(bias + colb + 128 * bj), b1 = *(const GAS f32x4*)(bias + colb + 128 * bj + 4);
#pragma unroll
            for (int ai = 0; ai < 2; ++ai)
#pragma unroll
                for (int m = 0; m < 4; ++m) {
                    const size_t off = (size_t)(row0 + ai * HALF + m * 16) * D + colb + 128 * bj;
                    f32x4 v0_ = acc[ai][bj][m][0] + b0, v1_ = acc[ai][bj][m][1] + b1;
#pragma unroll
                    for (int j = 0; j < 4; ++j) { v0_[j] = fsigmoid(v0_[j]) * osc; v1_[j] = fsigmoid(v1_[j]) * osc; }
                    if (t4 == 2) {
                        f32x4 x0, x1, f0, f1; unpack8(*(const GAS u32x4*)(V + off), x0, x1); unpack8(*(const GAS u32x4*)(VF + off), f0, f1);
                        v0_ = x0 + (f0 - x0) * v0_; v1_ = x1 + (f1 - x1) * v1_;
                    }
                    *(GAS u32x4*)(dst + off) = pack8(v0_, v1_);
                    asm volatile("" ::: "memory");
                }
        }
    }
};
struct EpiGPost {
    static constexpr bool PERM = true;
    const bf16_t *Y, *V; const float* BON; const float *ln_w, *ln_b; bf16_t* YG;
    __device__ __forceinline__ void operator()(const Acc& acc, const Unit& u, int wr, int wc, int fr, int fq) const {
        const int head = u.pn * 4 + wc;
        const int row0 = u.pm * BM + wr * 64 + fr;
        const int colb = head * 64 + 8 * fq;
#pragma unroll
        for (int ai = 0; ai < 2; ++ai)
#pragma unroll
            for (int m = 0; m < 4; ++m) {
                const int row = row0 + ai * HALF + m * 16;
                const size_t off = (size_t)row * D + colb;
                f32x4 y[2][2], v[2][2];
#pragma unroll
                for (int bj = 0; bj < 2; ++bj) { unpack8(*(const GAS u32x4*)(Y + off + 32 * bj), y[bj][0], y[bj][1]); unpack8(*(const GAS u32x4*)(V + off + 32 * bj), v[bj][0], v[bj][1]); }
                const float bs = BON[(size_t)row * 16 + head];
                float s = 0.f;
#pragma unroll
                for (int bj = 0; bj < 2; ++bj)
#pragma unroll
                    for (int n = 0; n < 2; ++n) s += (y[bj][n][0] + y[bj][n][1]) + (y[bj][n][2] + y[bj][n][3]);
                s += __shfl_xor(s, 16); s += __shfl_xor(s, 32);
                const float mean = s * (1.f / 64.f);
                float q = 0.f;
#pragma unroll
                for (int bj = 0; bj < 2; ++bj)
#pragma unroll
                    for (int n = 0; n < 2; ++n) { y[bj][n] = y[bj][n] - mean; q += (y[bj][n][0] * y[bj][n][0] + y[bj][n][1] * y[bj][n][1]) + (y[bj][n][2] * y[bj][n][2] + y[bj][n][3] * y[bj][n][3]); }
                q += __shfl_xor(q, 16); q += __shfl_xor(q, 32);
                const float rs = rsqrtf(q * (1.f / 64.f) + 64e-5f);
#pragma unroll
                for (int bj = 0; bj < 2; ++bj) {
                    f32x4 o[2];
#pragma unroll
                    for (int n = 0; n < 2; ++n) {
                        const f32x4 lw = *(const GAS f32x4*)(ln_w + colb + 32 * bj + 4 * n), lb = *(const GAS f32x4*)(ln_b + colb + 32 * bj + 4 * n);
                        o[n] = (y[bj][n] * rs * lw + lb + v[bj][n] * bs) * acc[ai][bj][m][n];
                    }
                    *(GAS u32x4*)(YG + off + 32 * bj) = pack8(o[0], o[1]);
                }
                asm volatile("" ::: "memory");
            }
    }
};
template <class Fn>
__device__ __forceinline__ void prep_mat(bf16_t* dst, int NR, int KC, int ldd, const Fn f, int& gw, int NGW, LAS float* scr, int lane) {
    const int nnb = NR / 32, ntile = nnb * (KC / 64);
    const int gw0 = gw; gw = (gw0 + NGW - ntile % NGW) % NGW;
    for (int it = gw0; it < ntile; it += NGW) {
        const int nb = it % nnb, kb = it / nnb, n0 = 32 * nb, k0 = 64 * kb;
#pragma unroll 8
        for (int i = 0; i < 32; ++i) { const int kk = 2 * i + (lane >> 5); scr[kk * 33 + (lane & 31)] = f(n0 + (lane & 31), k0 + kk); }
        LDS_WAIT(); asm volatile("" ::: "memory");
        const int c = lane & 7;
#pragma unroll
        for (int j = 0; j < 4; ++j) { const int n = (lane >> 3) + 8 * j; const LAS float* s = scr + (8 * c) * 33 + n;
            u32x4 o; o.x = cvt_pk_bf16(s[0 * 33], s[1 * 33]); o.y = cvt_pk_bf16(s[2 * 33], s[3 * 33]); o.z = cvt_pk_bf16(s[4 * 33], s[5 * 33]); o.w = cvt_pk_bf16(s[6 * 33], s[7 * 33]);
            *(GAS u32x4*)(dst + (size_t)(n0 + n) * ldd + k0 + 8 * c) = o; }
        LDS_WAIT(); asm volatile("" ::: "memory");
    }
}
__device__ __forceinline__ int headperm(int np) {
    const int t4 = np >> 8, p = np & 255, bj = p >> 7, wc = (p >> 5) & 3, e = p & 31;
    return t4 * 256 + wc * 64 + bj * 32 + e;
}
__device__ __forceinline__ void prep_hybrid(const float* w_in, const float* w_out, const float* pool_w, const float* pool_scale, bf16_t* WIN, bf16_t* WOUT, int gw, int NGW, LAS float* scr, int lane) {
    prep_mat(WIN, NPROJ, D, D, [=](int n, int k) -> float {
        const int src = n < 1024 ? headperm(n) : (n < 2048 ? n : n + 8);
        return w_in[(size_t)k * INC + src]; }, gw, NGW, scr, lane);
    prep_mat(WOUT, D, 512, D, [=](int n, int k) -> float { return w_out[(size_t)k * D + n]; }, gw, NGW, scr, lane);
    for (int it = gw; it < 1024; it += NGW) {
        const int g = it >> 8, c8 = (it >> 4) & 15, n = (it & 15) * 64 + lane;
        float a[8];
#pragma unroll
        for (int i = 0; i < 8; ++i) a[i] = 0.f;
        const float* pw = pool_w + ((size_t)g * 128 + c8 * 8) * 128;
#pragma unroll 4
        for (int d = 0; d < 128; ++d) {
            const float wv = w_out[(size_t)(512 + g * 128 + d) * D + n] * pool_scale[g * 128 + d];
#pragma unroll
            for (int i = 0; i < 8; ++i) a[i] += pw[i * 128 + d] * wv;
        }
        u32x4 o; o.x = cvt_pk_bf16(a[0], a[1]); o.y = cvt_pk_bf16(a[2], a[3]); o.z = cvt_pk_bf16(a[4], a[5]); o.w = cvt_pk_bf16(a[6], a[7]);
        *(GAS u32x4*)(WOUT + (size_t)n * D + 512 + g * 128 + c8 * 8) = o;
    }
}
__device__ __forceinline__ void prep_ffn(const float* wg, const float* wu, const float* wd, bf16_t* WGU, bf16_t* WD, int gw, int NGW, LAS float* scr, int lane) {
    prep_mat(WGU, 2 * F, D, D, [=](int n, int k) -> float {
        const int pn = n >> 8, p = n & 255, f = pn * 128 + (p & 127);
        const float* src = (p >> 7) ? wu : wg; return src[(size_t)k * F + f]; }, gw, NGW, scr, lane);
    prep_mat(WD, D, F, F, [=](int n, int k) -> float { return wd[(size_t)k * D + n]; }, gw, NGW, scr, lane);
}
__device__ __forceinline__ void prep_rwkv(const LAS unsigned* PL, int idx, bf16_t* WR2, bf16_t* WR3, bf16_t* WG, bf16_t* WO, int gw, int NGW, LAS float* scr, int lane) {
    const bool has_v = idx > 0;
    {
        const float* mu = ldp(PL, 13) + (size_t)idx * 6 * D;
        {
            const float* w_r = ldp(PL, 14) + (size_t)idx * D * D; const float* w_k = ldp(PL, 15) + (size_t)idx * D * D;
            prep_mat(WR2, 2048, 1024, 1024, [=](int n, int k) -> float { const float* W = (n >> 10) ? w_k : w_r; return W[(size_t)k * D + (n & 1023)]; }, gw, NGW, scr, lane);
        }
        {
            const float* w_v = ldp(PL, 16) + (size_t)idx * D * D;
            prep_mat(WR2 + (size_t)2048 * 1024, 1024, 2048, 2048, [=](int n, int kk) -> float {
                const int k = kk & 1023, hi = kk >> 10;
                const float m = mu[3 * D + k];
                return w_v[(size_t)k * D + n] * (hi ? m : 1.f - m); }, gw, NGW, scr, lane);
        }
        {
            const float* w1 = ldp(PL, 18) + (size_t)idx * D * 64; const float* a1 = ldp(PL, 21) + (size_t)idx * D * 64; const float* g1 = ldp(PL, 23) + (size_t)idx * D * 160; const float* v1 = ldp(PL, 32);
            prep_mat(WR2 + (size_t)2048 * 1024 + (size_t)1024 * 2048, 512, 2048, 2048, [=](int n, int kk) -> float {
                const int k = kk & 1023, hi = kk >> 10;
                float wv; int mi;
                if (n < 64) { wv = w1[(size_t)k * 64 + n]; mi = 1; }
                else if (n < 128) { wv = a1[(size_t)k * 64 + (n - 64)]; mi = 4; }
                else if (n < 288) { wv = g1[(size_t)k * 160 + (n - 128)]; mi = 5; }
                else if (n < 320 && has_v) { wv = v1[(size_t)k * 32 + (n - 288)]; mi = 3; }
                else return 0.f;
                const float m = mu[mi * D + k];
                return wv * (hi ? m : 1.f - m); }, gw, NGW, scr, lane);
        }
    }
    {
        const float* w2 = ldp(PL, 19) + (size_t)idx * 64 * D; const float* a2 = ldp(PL, 22) + (size_t)idx * 64 * D; const float* v2 = ldp(PL, 33);
        prep_mat(WR3, has_v ? 3072 : 2048, 384, 384, [=](int n, int k) -> float {
            const int t = n >> 10, c = n & 1023;
            if (t == 0) return k < 64 ? w2[(size_t)k * D + c] : 0.f;
            if (t == 1) return (k >= 64 && k < 128) ? a2[(size_t)(k - 64) * D + c] : 0.f;
            return (k >= 288 && k < 320) ? v2[(size_t)(k - 288) * D + c] : 0.f; }, gw, NGW, scr, lane);
    }
    {
        const float* g2 = ldp(PL, 24) + (size_t)idx * 160 * D;
        prep_mat(WG, D, 256, 256, [=](int n, int k) -> float { return k < 160 ? g2[(size_t)k * D + headperm(n)] : 0.f; }, gw, NGW, scr, lane);
    }
    {
        const float* w_o = ldp(PL, 30) + (size_t)idx * D * D;
        prep_mat(WO, D, D, D, [=](int n, int k) -> float { return w_o[(size_t)k * D + n]; }, gw, NGW, scr, lane);
    }
}

template <int MODE, bool XBF>
__device__ __forceinline__ void rmsnorm_rows(const void* x, const float* gain, bf16_t* H, int gw, int NGW, int lane, const LAS float* WF, const float* fbias, float* LF) {
    constexpr int RB = MODE == 1 ? 4 : 8;
    f32x4 g[2][2];
#pragma unroll
    for (int j = 0; j < 2; ++j) { g[j][0] = *(const GAS f32x4*)(gain + 512 * j + lane * 8); g[j][1] = *(const GAS f32x4*)(gain + 512 * j + lane * 8 + 4); }
    for (int row0 = gw * RB; row0 < T; row0 += NGW * RB) {
        f32x4 v[RB][2][2]; float s[RB];
#pragma unroll
        for (int r = 0; r < RB; ++r)
#pragma unroll
            for (int j = 0; j < 2; ++j) { const size_t xo = (size_t)(row0 + r) * D + 512 * j + lane * 8;
                if (XBF) unpack8h(*(const GAS u32x4*)((const bf16_t*)x + xo), v[r][j][0], v[r][j][1]);
                else { v[r][j][0] = *(const GAS f32x4*)((const float*)x + xo); v[r][j][1] = *(const GAS f32x4*)((const float*)x + xo + 4); } }
#pragma unroll
        for (int r = 0; r < RB; ++r) { s[r] = 0.f;
#pragma unroll
            for (int j = 0; j < 2; ++j)
#pragma unroll
                for (int e = 0; e < 2; ++e) s[r] += (v[r][j][e][0] * v[r][j][e][0] + v[r][j][e][1] * v[r][j][e][1]) + (v[r][j][e][2] * v[r][j][e][2] + v[r][j][e][3] * v[r][j][e][3]); }
#pragma unroll
        for (int o = 1; o < 64; o <<= 1)
#pragma unroll
            for (int r = 0; r < RB; ++r) s[r] += __shfl_xor(s[r], o);
#pragma unroll
        for (int r = 0; r < RB; ++r) {
            const int row = row0 + r;
            const float rstd = rsqrtf(s[r] * (1.f / D) + 1e-6f);
            const size_t hrow = MODE == 2 ? (size_t)row + (row >> 12) + 1 : (size_t)row;
#pragma unroll
            for (int j = 0; j < 2; ++j) { v[r][j][0] = v[r][j][0] * rstd * g[j][0]; v[r][j][1] = v[r][j][1] * rstd * g[j][1];
                *(GAS u32x4*)(H + hrow * D + 512 * j + lane * 8) = pack8(v[r][j][0], v[r][j][1]); }
        }
        if (MODE == 1) {
            float dt[RB][8];
#pragma unroll
            for (int r = 0; r < RB; ++r)
#pragma unroll
                for (int h = 0; h < 8; ++h) dt[r][h] = 0.f;
#pragma unroll
            for (int j = 0; j < 2; ++j)
#pragma unroll
                for (int e = 0; e < 2; ++e)
#pragma unroll
                    for (int c = 0; c < 4; ++c) {
                        const LAS float* wp = WF + (512 * j + lane * 8 + 4 * e + c) * 8;
                        const f32x4 w0 = *(const LAS f32x4*)wp, w1 = *(const LAS f32x4*)(wp + 4);
#pragma unroll
                        for (int r = 0; r < RB; ++r) {
                            const float hv = v[r][j][e][c];
                            dt[r][0] += hv * w0[0]; dt[r][1] += hv * w0[1]; dt[r][2] += hv * w0[2]; dt[r][3] += hv * w0[3];
                            dt[r][4] += hv * w1[0]; dt[r][5] += hv * w1[1]; dt[r][6] += hv * w1[2]; dt[r][7] += hv * w1[3];
                        }
                    }
            const bool hi32 = (lane & 32) != 0, hi16 = (lane & 16) != 0, hi8 = (lane & 8) != 0;
            const int hsel = (hi32 ? 4 : 0) + (hi16 ? 2 : 0) + (hi8 ? 1 : 0);
            const float fb = fbias[hsel];
#pragma unroll
            for (int r = 0; r < RB; ++r) {
                float d4[4], d2[2], d1;
#pragma unroll
                for (int k = 0; k < 4; ++k) { const float send = hi32 ? dt[r][k] : dt[r][k + 4], keep = hi32 ? dt[r][k + 4] : dt[r][k]; d4[k] = keep + __shfl_xor(send, 32); }
#pragma unroll
                for (int k = 0; k < 2; ++k) { const float send = hi16 ? d4[k] : d4[k + 2], keep = hi16 ? d4[k + 2] : d4[k]; d2[k] = keep + __shfl_xor(send, 16); }
                { const float send = hi8 ? d2[0] : d2[1], keep = hi8 ? d2[1] : d2[0]; d1 = keep + __shfl_xor(send, 8); }
                d1 += __shfl_xor(d1, 4); d1 += __shfl_xor(d1, 2); d1 += __shfl_xor(d1, 1);
                if ((lane & 7) == 0) {
                    const int row = row0 + r;
                    const float z = d1 + fb;
                    LF[((size_t)(row >> 12) * 8 + hsel) * S + (row & 4095)] = fminf(z, 0.f) - log1pf(__expf(-fabsf(z)));
                }
            }
        }
    }
}

__device__ __forceinline__ void rmsnorm_rows_rwkv(const bf16_t* x, const float* gain, const float* mu_r, const float* mu_k, bf16_t* H, bf16_t* XR, bf16_t* XK, int gw, int NGW, int lane) {
    constexpr int RB = 4;
    f32x4 g[2][2], mr[2][2], mk[2][2];
#pragma unroll
    for (int j = 0; j < 2; ++j)
#pragma unroll
        for (int e = 0; e < 2; ++e) { const int co = 512 * j + lane * 8 + 4 * e; g[j][e] = *(const GAS f32x4*)(gain + co); mr[j][e] = *(const GAS f32x4*)(mu_r + co); mk[j][e] = *(const GAS f32x4*)(mu_k + co); }
    for (int row0 = gw * RB; row0 < T; row0 += NGW * RB) {
        const bool first = (row0 & 4095) == 0;
        f32x4 v[RB + 1][2][2]; float s[RB + 1];
#pragma unroll
        for (int r = 0; r <= RB; ++r)
#pragma unroll
            for (int j = 0; j < 2; ++j) unpack8h(*(const GAS u32x4*)(x + (size_t)(row0 - 1 + r + (first && r == 0 ? 1 : 0)) * D + 512 * j + lane * 8), v[r][j][0], v[r][j][1]);
#pragma unroll
        for (int r = 0; r <= RB; ++r) { s[r] = 0.f;
#pragma unroll
            for (int j = 0; j < 2; ++j)
#pragma unroll
                for (int e = 0; e < 2; ++e) s[r] += (v[r][j][e][0] * v[r][j][e][0] + v[r][j][e][1] * v[r][j][e][1]) + (v[r][j][e][2] * v[r][j][e][2] + v[r][j][e][3] * v[r][j][e][3]); }
#pragma unroll
        for (int o = 1; o < 64; o <<= 1)
#pragma unroll
            for (int r = 0; r <= RB; ++r) s[r] += __shfl_xor(s[r], o);
#pragma unroll
        for (int r = 0; r <= RB; ++r) {
            const float rstd = (first && r == 0) ? 0.f : rsqrtf(s[r] * (1.f / D) + 1e-6f);
#pragma unroll
            for (int j = 0; j < 2; ++j)
#pragma unroll
                for (int e = 0; e < 2; ++e) v[r][j][e] = v[r][j][e] * rstd * g[j][e];
        }
#pragma unroll
        for (int r = 1; r <= RB; ++r) {
            const int row = row0 + r - 1;
            const size_t hrow = (size_t)row + (row >> 12) + 1;
#pragma unroll
            for (int j = 0; j < 2; ++j) {
                const size_t co = (size_t)512 * j + lane * 8;
                *(GAS u32x4*)(H + hrow * D + co) = pack8(v[r][j][0], v[r][j][1]);
                const f32x4 d0 = v[r - 1][j][0] - v[r][j][0], d1 = v[r - 1][j][1] - v[r][j][1];
                *(GAS u32x4*)(XR + (size_t)row * D + co) = pack8(v[r][j][0] + d0 * mr[j][0], v[r][j][1] + d1 * mr[j][1]);
                *(GAS u32x4*)(XK + (size_t)row * D + co) = pack8(v[r][j][0] + d0 * mk[j][0], v[r][j][1] + d1 * mk[j][1]);
            }
            if (first && r == 1) {
#pragma unroll
                for (int j = 0; j < 2; ++j) *(GAS u32x4*)(H + (hrow - 1) * D + 512 * j + lane * 8) = (u32x4){0u, 0u, 0u, 0u};
            }
        }
    }
}

constexpr int KPITCH = 144, VPITCH = 136;
__device__ __forceinline__ void attn_phase(LAS unsigned char* lds, const int wid, const bf16_t* P, const float* LF, bf16_t* CAT, const float* qgain, const float* kgain) {
    LAS float* CB = (LAS float*)lds;
    LAS unsigned char* KB = lds + 16384;
    LAS unsigned char* VB = KB + 2 * 64 * KPITCH;
    LAS float* red = (LAS float*)(VB + 2 * 64 * VPITCH);
    LAS unsigned* flg = (LAS unsigned*)(red + 16);
    float sbound;
    {
        float gq = fabsf(qgain[lane_id()]), gk = fabsf(kgain[lane_id()]);
#pragma unroll
        for (int o = 1; o < 64; o <<= 1) { gq = fmaxf(gq, __shfl_xor(gq, o)); gk = fmaxf(gk, __shfl_xor(gk, o)); }
        sbound = 64.f * QSCALE * gq * gk * 1.03f + 40.f;
    }
    const int lane = lane_id(), tid = wid * 64 + lane, r32 = lane & 31, hh = lane >> 5;
    const int ldkey = tid >> 3, ldd8 = (tid & 7) * 8;
    for (int w = blockIdx.x; w < 256; w += gridDim.x) {
        const int bh = w >> 2, jq = w & 3, b = bh >> 3, hd = bh & 7;
        __syncthreads();
        {
            const f32x4 l0 = *(const GAS f32x4*)(LF + (size_t)bh * S + tid * 8), l1 = *(const GAS f32x4*)(LF + (size_t)bh * S + tid * 8 + 4);
            float c[8]; c[0] = l0[0]; c[1] = c[0] + l0[1]; c[2] = c[1] + l0[2]; c[3] = c[2] + l0[3]; c[4] = c[3] + l1[0]; c[5] = c[4] + l1[1]; c[6] = c[5] + l1[2]; c[7] = c[6] + l1[3];
            float inc = c[7];
#pragma unroll
            for (int o = 1; o < 64; o <<= 1) { const float t = __shfl_up(inc, o); if (lane >= o) inc += t; }
            if (lane == 63) red[wid] = inc;
            __syncthreads();
            float base = inc - c[7];
            for (int i = 0; i < wid; ++i) base += red[i];
#pragma unroll
            for (int i = 0; i < 8; ++i) CB[tid * 8 + i] = -(base + c[i]) * LOG2E;
        }
        __syncthreads();
        const size_t tok0 = (size_t)b * S;
#pragma unroll 1
        for (int ui = 0; ui < 4; ++ui) {
            const int qb = ui == 0 ? jq : (ui == 1 ? 15 - jq : (ui == 2 ? 7 - jq : 8 + jq));
            const int q0 = qb * 256 + wid * 32, qrow = q0 + r32;
            bf16x8 qf[4];
#pragma unroll
            for (int ds = 0; ds < 4; ++ds) qf[ds] = *(const GAS bf16x8*)(P + (tok0 + qrow) * NPROJ + hd * 64 + 16 * ds + 8 * hh);
            f32x16 O[2];
#pragma unroll
            for (int i = 0; i < 16; ++i) { O[0][i] = 0.f; O[1][i] = 0.f; }
            float mrun = -1e30f, lsum = 0.f;
            unsigned done_w = 0u;
            const int ntile = 4 * qb + 4;
            u32x4 kreg, vreg;
            {
                const size_t gk = (tok0 + (size_t)(ntile - 1) * 64 + ldkey) * NPROJ + hd * 64 + ldd8;
                kreg = *(const GAS u32x4*)(P + gk + 512); vreg = *(const GAS u32x4*)(P + gk + 1024);
                *(LAS u32x4*)(KB + ldkey * KPITCH + ldd8 * 2) = kreg;
                LAS unsigned char* vb = VB + ldd8 * VPITCH + ldkey * 2;
                *(LAS bf16_t*)(vb + 0 * VPITCH) = (bf16_t)(vreg.x & 0xffff); *(LAS bf16_t*)(vb + 1 * VPITCH) = (bf16_t)(vreg.x >> 16);
                *(LAS bf16_t*)(vb + 2 * VPITCH) = (bf16_t)(vreg.y & 0xffff); *(LAS bf16_t*)(vb + 3 * VPITCH) = (bf16_t)(vreg.y >> 16);
                *(LAS bf16_t*)(vb + 4 * VPITCH) = (bf16_t)(vreg.z & 0xffff); *(LAS bf16_t*)(vb + 5 * VPITCH) = (bf16_t)(vreg.z >> 16);
                *(LAS bf16_t*)(vb + 6 * VPITCH) = (bf16_t)(vreg.w & 0xffff); *(LAS bf16_t*)(vb + 7 * VPITCH) = (bf16_t)(vreg.w >> 16);
            }
            __syncthreads();
#pragma unroll 1
            for (int it = 0; it < ntile; ++it) {
                const int kt = ntile - 1 - it, cb = it & 1;
                const bool more = it + 1 < ntile;
                if (more) {
                    const size_t gk = (tok0 + (size_t)(kt - 1) * 64 + ldkey) * NPROJ + hd * 64 + ldd8;
                    kreg = *(const GAS u32x4*)(P + gk + 512); vreg = *(const GAS u32x4*)(P + gk + 1024);
                }
                if (kt * 64 <= q0 + 31 && !done_w) {
                    const LAS unsigned char* kb_ = KB + cb * 64 * KPITCH;
                    const LAS unsigned char* vb_ = VB + cb * 64 * VPITCH;
                    f32x16 sacc[2];
                    __builtin_amdgcn_s_setprio(1);
#pragma unroll
                    for (int kb = 0; kb < 2; ++kb) {
#pragma unroll
                        for (int i = 0; i < 16; ++i) sacc[kb][i] = 0.f;
#pragma unroll
                        for (int ds = 0; ds < 4; ++ds) {
                            const bf16x8 a = *(const LAS bf16x8*)(kb_ + (kb * 32 + r32) * KPITCH + (16 * ds + 8 * hh) * 2);
                            sacc[kb] = __builtin_amdgcn_mfma_f32_32x32x16_bf16(a, qf[ds], sacc[kb], 0, 0, 0);
                        }
                    }
                    __builtin_amdgcn_s_setprio(0);
                    const bool diag = (kt * 64 + 63 > q0);
                    float mloc = -1e30f;
#pragma unroll
                    for (int kb = 0; kb < 2; ++kb)
#pragma unroll
                        for (int i4 = 0; i4 < 4; ++i4) {
                            const int kl = kb * 32 + 8 * i4 + 4 * hh;
                            const f32x4 bias = *(const LAS f32x4*)(CB + kt * 64 + kl);
#pragma unroll
                            for (int jj = 0; jj < 4; ++jj) {
                                float sv = sacc[kb][4 * i4 + jj] + bias[jj];
                                if (diag && (kt * 64 + kl + jj > qrow)) sv = -1e30f;
                                sacc[kb][4 * i4 + jj] = sv; mloc = fmaxf(mloc, sv);
                            }
                        }
                    mloc = fmaxf(mloc, __shfl_xor(mloc, 32));
                    const float mnew = fmaxf(mrun, mloc);
                    const float alpha = fexp2(mrun - mnew); mrun = mnew;
                    float ps = 0.f;
#pragma unroll
                    for (int kb = 0; kb < 2; ++kb)
#pragma unroll
                        for (int i = 0; i < 16; ++i) { const float p = fexp2(sacc[kb][i] - mnew); sacc[kb][i] = p; ps += p; }
                    lsum = lsum * alpha + ps;
#pragma unroll
                    for (int i = 0; i < 16; ++i) { O[0][i] *= alpha; O[1][i] *= alpha; }
#pragma unroll
                    for (int kb = 0; kb < 2; ++kb)
#pragma unroll
                        for (int s2 = 0; s2 < 2; ++s2) {
                            u32x4 pw; pw.x = cvt_pk_bf16(sacc[kb][8 * s2 + 0], sacc[kb][8 * s2 + 1]); pw.y = cvt_pk_bf16(sacc[kb][8 * s2 + 2], sacc[kb][8 * s2 + 3]);
                            pw.z = cvt_pk_bf16(sacc[kb][8 * s2 + 4], sacc[kb][8 * s2 + 5]); pw.w = cvt_pk_bf16(sacc[kb][8 * s2 + 6], sacc[kb][8 * s2 + 7]);
                            const bf16x8 pf = __builtin_bit_cast(bf16x8, pw);
#pragma unroll
                            for (int db = 0; db < 2; ++db) {
                                const LAS unsigned char* vp = vb_ + (db * 32 + r32) * VPITCH + (kb * 32 + 16 * s2 + 4 * hh) * 2;
                                const s16x4 lo = *(const LAS s16x4*)vp, hi = *(const LAS s16x4*)(vp + 16);
                                const bf16x8 av = __builtin_shufflevector(lo, hi, 0, 1, 2, 3, 4, 5, 6, 7);
                                O[db] = __builtin_amdgcn_mfma_f32_32x32x16_bf16(av, pf, O[db], 0, 0, 0);
                            }
                        }
                }
                if (kt * 64 <= q0 + 31 && !done_w && kt > 0) {
                    float mmin = mrun;
#pragma unroll
                    for (int o = 1; o < 32; o <<= 1) mmin = fminf(mmin, __shfl_xor(mmin, o));
                    done_w = (sbound + CB[kt * 64 - 1] < mmin) ? 1u : 0u;
                }
                if (lane == 0) flg[(it & 1) * 8 + wid] = done_w;
                if (more) {
                    const int nb = cb ^ 1;
                    *(LAS u32x4*)(KB + nb * 64 * KPITCH + ldkey * KPITCH + ldd8 * 2) = kreg;
                    LAS unsigned char* vb = VB + nb * 64 * VPITCH + ldd8 * VPITCH + ldkey * 2;
                    *(LAS bf16_t*)(vb + 0 * VPITCH) = (bf16_t)(vreg.x & 0xffff); *(LAS bf16_t*)(vb + 1 * VPITCH) = (bf16_t)(vreg.x >> 16);
                    *(LAS bf16_t*)(vb + 2 * VPITCH) = (bf16_t)(vreg.y & 0xffff); *(LAS bf16_t*)(vb + 3 * VPITCH) = (bf16_t)(vreg.y >> 16);
                    *(LAS bf16_t*)(vb + 4 * VPITCH) = (bf16_t)(vreg.z & 0xffff); *(LAS bf16_t*)(vb + 5 * VPITCH) = (bf16_t)(vreg.z >> 16);
                    *(LAS bf16_t*)(vb + 6 * VPITCH) = (bf16_t)(vreg.w & 0xffff); *(LAS bf16_t*)(vb + 7 * VPITCH) = (bf16_t)(vreg.w >> 16);
                }
                __syncthreads();
                {
                    const u32x4 f0 = *(const LAS u32x4*)(flg + (it & 1) * 8), f1 = *(const LAS u32x4*)(flg + (it & 1) * 8 + 4);
                    if ((f0.x & f0.y & f0.z & f0.w & f1.x & f1.y & f1.z & f1.w) != 0u) break;
                }
            }
            const float ltot = lsum + __shfl_xor(lsum, 32);
            const float inv = 1.f / ltot;
#pragma unroll
            for (int db = 0; db < 2; ++db)
#pragma unroll
                for (int i4 = 0; i4 < 4; ++i4) {
                    const int d0 = db * 32 + 8 * i4 + 4 * hh;
                    const u32x2 gt = *(const GAS u32x2*)(P + (tok0 + qrow) * NPROJ + 1536 + hd * 64 + d0);
                    u32x2 o; o.x = cvt_pk_bf16(O[db][4 * i4 + 0] * inv * bf_lo(gt.x), O[db][4 * i4 + 1] * inv * bf_hi(gt.x));
                    o.y = cvt_pk_bf16(O[db][4 * i4 + 2] * inv * bf_lo(gt.y), O[db][4 * i4 + 3] * inv * bf_hi(gt.y));
                    *(GAS u32x2*)(CAT + (tok0 + qrow) * D + hd * 64 + d0) = o;
                }
        }
    }
    for (int item = blockIdx.x * 512 + tid; item < T * 64; item += gridDim.x * 512) {
        const int t = item >> 6, c = (item & 63) * 8, g = c >> 7, wdw = 2 << g, pos = t & 4095;
        const int cnt = pos + 1 < wdw ? pos + 1 : wdw;
        f32x4 s0 = {0.f, 0.f, 0.f, 0.f}, s1 = s0, u0 = s0, u1 = s0;
        for (int j = 0; j < cnt; ++j) {
            f32x4 a, bq; unpack8(*(const GAS u32x4*)(P + (size_t)(t - j) * NPROJ + 2048 + c), a, bq);
            if (j == 0) { u0 = a; u1 = bq; }
            s0 += a; s1 += bq;
        }
        const float ic = 1.f / (float)cnt;
        *(GAS u32x4*)(CAT + (size_t)t * D + 512 + c) = pack8(s0 * ic - u0, s1 * ic - u1);
    }
}

constexpr int TC = 32;
__device__ __forceinline__ void scan_phase(LAS unsigned char* lds, const int wid, const bf16_t* R, const bf16_t* K, const bf16_t* V, const bf16_t* W, const bf16_t* A,
                                           const float* k_k, const float* k_a, const float* r_k, bf16_t* Y, float* BON) {
    const int tid = wid * 64 + lane_id(), row = tid >> 4, kq = tid & 15;
    for (int unit = blockIdx.x; unit < 256; unit += gridDim.x) {
        const int bh = unit >> 1, half = unit & 1, b = bh >> 4, h = bh & 15;
        const f32x4 kkp = *(const GAS f32x4*)(k_k + h * 64 + kq * 4), kap = *(const GAS f32x4*)(k_a + h * 64 + kq * 4), rkp = *(const GAS f32x4*)(r_k + h * 64 + kq * 4);
        float s0 = 0.f, s1 = 0.f, s2 = 0.f, s3 = 0.f;
        const size_t tokb = (size_t)b * S;
        const size_t gvec = (tokb + row) * D + h * 64 + kq * 4;
        const size_t gv = (tokb + row) * D + h * 64 + half * 32 + kq * 2;
        u32x2 rr, kr, wr_, ar; unsigned vr;
        rr = *(const GAS u32x2*)(R + gvec); kr = *(const GAS u32x2*)(K + gvec); wr_ = *(const GAS u32x2*)(W + gvec); ar = *(const GAS u32x2*)(A + gvec); vr = *(const GAS unsigned*)(V + gv);
        __syncthreads();
#pragma unroll 1
        for (int c = 0; c < S / TC; ++c) {
            LAS float* vec = (LAS float*)(lds + (c & 1) * 45056);
            LAS float* vvb = vec + 5 * TC * 64;
            LAS float* yb = (LAS float*)(lds + 90112 + (c & 1) * 4096);
            {
                const f32x4 kx = {bf_lo(kr.x), bf_hi(kr.x), bf_lo(kr.y), bf_hi(kr.y)};
                const f32x4 ax = {bf_lo(ar.x), bf_hi(ar.x), bf_lo(ar.y), bf_hi(ar.y)};
                const f32x4 wx = {bf_lo(wr_.x), bf_hi(wr_.x), bf_lo(wr_.y), bf_hi(wr_.y)};
                const f32x4 rx = {bf_lo(rr.x), bf_hi(rr.x), bf_lo(rr.y), bf_hi(rr.y)};
                f32x4 kk = kx * kkp;
                float ss = (kk[0] * kk[0] + kk[1] * kk[1]) + (kk[2] * kk[2] + kk[3] * kk[3]);
                ss = reduce16(ss);
                const float inv = 1.f / fmaxf(sqrtf(ss), 1e-12f);
                kk = kk * inv;
                const f32x4 km = kx * (1.f + (ax - 1.f) * kap);
                f32x4 dec; dec[0] = fexp2(-wx[0] * LOG2E); dec[1] = fexp2(-wx[1] * LOG2E); dec[2] = fexp2(-wx[2] * LOG2E); dec[3] = fexp2(-wx[3] * LOG2E);
                const f32x4 rkm = rx * km * rkp;
                float bs = (rkm[0] + rkm[1]) + (rkm[2] + rkm[3]);
                bs = reduce16(bs);
                if (half == 0 && kq == 0) BON[(tokb + (size_t)c * TC + row) * 16 + h] = bs;
                LAS float* vp = vec + row * 64 + kq * 4;
                *(LAS f32x4*)(vp + 0 * TC * 64) = -kk;
                *(LAS f32x4*)(vp + 1 * TC * 64) = kk * ax;
                *(LAS f32x4*)(vp + 2 * TC * 64) = dec;
                *(LAS f32x4*)(vp + 3 * TC * 64) = km;
                *(LAS f32x4*)(vp + 4 * TC * 64) = rx;
                vvb[row * 32 + kq * 2] = bf_lo(vr); vvb[row * 32 + kq * 2 + 1] = bf_hi(vr);
            }
            __syncthreads();
            if (c > 0) {
                const LAS float* pyb = (const LAS float*)(lds + 90112 + ((c - 1) & 1) * 4096);
                *(GAS unsigned*)(Y + gv + (size_t)(c - 1) * TC * D) = cvt_pk_bf16(pyb[row * 32 + kq * 2], pyb[row * 32 + kq * 2 + 1]);
            }
            if (c + 1 < S / TC) {
                const size_t o = (size_t)(c + 1) * TC * D;
                rr = *(const GAS u32x2*)(R + gvec + o); kr = *(const GAS u32x2*)(K + gvec + o); wr_ = *(const GAS u32x2*)(W + gvec + o); ar = *(const GAS u32x2*)(A + gvec + o); vr = *(const GAS unsigned*)(V + gv + o);
            }
#pragma unroll 1
            for (int tb = 0; tb < TC / 16; ++tb) {
                const LAS float* vp0 = vec + tb * 16 * 64 + kq * 4;
                const LAS float* vv0 = vvb + tb * 16 * 32 + row;
                f32x4 av = *(const LAS f32x4*)(vp0 + 0 * TC * 64), bv = *(const LAS f32x4*)(vp0 + 1 * TC * 64), dv = *(const LAS f32x4*)(vp0 + 2 * TC * 64),
                      kv = *(const LAS f32x4*)(vp0 + 3 * TC * 64), rv = *(const LAS f32x4*)(vp0 + 4 * TC * 64);
                float vv = vv0[0];
                float ykeep = 0.f;
#pragma unroll
                for (int j = 0; j < 16; ++j) {
                    f32x4 av_n = av, bv_n = bv, dv_n = dv, kv_n = kv, rv_n = rv; float vv_n = vv;
                    if (j < 15) {
                        const LAS float* vp = vp0 + (j + 1) * 64;
                        av_n = *(const LAS f32x4*)(vp + 0 * TC * 64); bv_n = *(const LAS f32x4*)(vp + 1 * TC * 64); dv_n = *(const LAS f32x4*)(vp + 2 * TC * 64);
                        kv_n = *(const LAS f32x4*)(vp + 3 * TC * 64); rv_n = *(const LAS f32x4*)(vp + 4 * TC * 64); vv_n = vv0[(j + 1) * 32];
                    }
                    float t, t2, u, u2;
                    SC_MUL(t, s0, av[0]); SC_FMAC(t, s1, av[1]); SC_MUL(t2, s2, av[2]); SC_FMAC(t2, s3, av[3]);
                    float sa = t + t2;
                    sa = reduce16(sa);
                    SC_MUL(s0, s0, dv[0]); SC_MUL(s1, s1, dv[1]); SC_MUL(s2, s2, dv[2]); SC_MUL(s3, s3, dv[3]);
                    SC_FMAC(s0, sa, bv[0]); SC_FMAC(s1, sa, bv[1]); SC_FMAC(s2, sa, bv[2]); SC_FMAC(s3, sa, bv[3]);
                    SC_FMAC(s0, vv, kv[0]); SC_FMAC(s1, vv, kv[1]); SC_FMAC(s2, vv, kv[2]); SC_FMAC(s3, vv, kv[3]);
                    SC_MUL(u, s0, rv[0]); SC_FMAC(u, s1, rv[1]); SC_MUL(u2, s2, rv[2]); SC_FMAC(u2, s3, rv[3]);
                    float y = u + u2;
                    y = reduce16(y);
                    ykeep = (kq == j) ? y : ykeep;
                    av = av_n; bv = bv_n; dv = dv_n; kv = kv_n; rv = rv_n; vv = vv_n;
                }
                yb[(tb * 16 + kq) * 32 + row] = ykeep;
            }
        }
        __syncthreads();
        {
            const LAS float* pyb = (const LAS float*)(lds + 90112 + ((S / TC - 1) & 1) * 4096);
            *(GAS unsigned*)(Y + gv + (size_t)(S / TC - 1) * TC * D) = cvt_pk_bf16(pyb[row * 32 + kq * 2], pyb[row * 32 + kq * 2 + 1]);
        }
        __syncthreads();
    }
}
#define SC2_BAR() do { asm volatile("s_waitcnt lgkmcnt(0)" ::: "memory"); __builtin_amdgcn_s_barrier(); asm volatile("" ::: "memory"); } while (0)
constexpr int CL = 16, NCH = S / CL;
constexpr int P_BK = 0, P_AR = 4608, P_BKT = 9216, P_VT = 14336, P_LAM = 15616, P_SIZE = 15872;
constexpr int Q_MKB = 0, Q_NBR = 512, Q_NKR = 1024, Q_TT = 1536, Q_SIZE = 2048;
constexpr int L_P = 0, L_Q = 3 * P_SIZE, L_MAB = L_Q + 2 * Q_SIZE, L_S16 = L_MAB + 1024, L_XU = L_S16 + 2 * 2304, L_CE = L_XU + 2 * 640, L_END2 = L_CE + 2 * 4096;
__device__ __forceinline__ f32x4 mfma16(const s16x4 a, const s16x4 b, const f32x4 c) { return __builtin_amdgcn_mfma_f32_16x16x16bf16_1k(a, b, c, 0, 0, 0); }
__device__ __forceinline__ f32x4 mfma32(const bf16x8 a, const bf16x8 b, const f32x4 c) { return __builtin_amdgcn_mfma_f32_16x16x32_bf16(a, b, c, 0, 0, 0); }
#define MF_SETTLE(v) do { } while (0)
__device__ __forceinline__ bf16_t f2bf(float x) { return (bf16_t)(cvt_pk_bf16(x, 0.f) & 0xffffu); }
__device__ __forceinline__ u32x2 pack4(const f32x4 v) { u32x2 o; o.x = cvt_pk_bf16(v[0], v[1]); o.y = cvt_pk_bf16(v[2], v[3]); return o; }

__device__ __forceinline__ void scan_phase2(LAS unsigned char* lds, const int wid, const bf16_t* R, const bf16_t* K, const bf16_t* V, const bf16_t* W, const bf16_t* A,
                                            const float* k_k, const float* k_a, const float* r_k, bf16_t* Y, float* BON) {
    const int lane = lane_id(), l15 = lane & 15, q = lane >> 4;
    for (int unit = blockIdx.x; unit < 256; unit += gridDim.x) {
        const int bh = unit >> 1, half = unit & 1, b = bh >> 4, h = bh & 15;
        const size_t tokb = (size_t)b * S;
        __syncthreads();
        if (wid == 7) {
            LAS float* CE0 = (LAS float*)(lds + L_CE);
            float c = 0.f;
#pragma unroll
            for (int i = 0; i < 16; ++i) { c += __uint_as_float((unsigned)W[(tokb + i) * D + h * 64 + lane] << 16); CE0[i * 64 + lane] = c; }
        }
        __syncthreads();
        if (wid == 2 || (wid >= 4 && wid < 7)) {
            const int idx = (wid == 2 ? 0 : wid - 3) * 64 + lane, s = idx >> 4, kq = idx & 15;
            const f32x4 kkp = *(const GAS f32x4*)(k_k + h * 64 + kq * 4), kap = *(const GAS f32x4*)(k_a + h * 64 + kq * 4), rkp = *(const GAS f32x4*)(r_k + h * 64 + kq * 4);
            const size_t gbase = tokb * D + h * 64;
            const unsigned lo_s = (unsigned)(s * D + kq * 4) * 2u;
            u32x2 rr, kr, ar, wr_;
#define SC2_LOAD(itn) do { const char* Rp = (const char*)(R + gbase + (size_t)(itn) * CL * D); const char* Kp = (const char*)(K + gbase + (size_t)(itn) * CL * D); \
                const char* Ap = (const char*)(A + gbase + (size_t)(itn) * CL * D); const char* Wp = (const char*)(W + gbase + (size_t)(itn) * CL * D); \
                asm volatile("" : "+s"(Rp), "+s"(Kp), "+s"(Ap), "+s"(Wp)); \
                rr = *(const GAS u32x2*)(Rp + lo_s); kr = *(const GAS u32x2*)(Kp + lo_s); ar = *(const GAS u32x2*)(Ap + lo_s); wr_ = *(const GAS u32x2*)(Wp + lo_s); } while (0)
            SC2_LOAD(0);
#pragma unroll 1
            for (int it = 0; it < NCH + 2; ++it) {
                if (it < NCH) for (int rp_ = 0; rp_ < 1 + ((MK_SC2P >> 1) & 1); ++rp_) {
                    LAS unsigned char* Pb = lds + L_P + (it % 3) * P_SIZE;
                    const f32x4 kx = unpack4(kr), ax = unpack4(ar), rx = unpack4(rr);
                    f32x4 kk = kx * kkp;
                    float ss = (kk[0] * kk[0] + kk[1] * kk[1]) + (kk[2] * kk[2] + kk[3] * kk[3]);
                    ss = reduce16(ss);
                    kk = kk * (1.f / fmaxf(sqrtf(ss), 1e-12f));
                    const f32x4 km = kx * (1.f + (ax - 1.f) * kap);
                    const f32x4 rkm = rx * km * rkp;
                    float bs = (rkm[0] + rkm[1]) + (rkm[2] + rkm[3]);
                    bs = reduce16(bs);
                    if (half == 0 && kq == 0) BON[(tokb + (size_t)it * CL + s) * 16 + h] = bs;
                    const f32x4 cum = *(const LAS f32x4*)(lds + L_CE + (it & 1) * 4096 + (s * 64 + kq * 4) * 4);
                    const f32x4 ews = unpack4(wr_);
                    f32x4 e1, e2, ed;
#pragma unroll
                    for (int i = 0; i < 4; ++i) { e1[i] = fexp2(cum[i] * LOG2E); e2[i] = frcp(e1[i]); ed[i] = fexp2(ews[i] * LOG2E); }
                    const f32x4 av = -kk, bv = kk * ax;
                    const f32x4 bbar = bv * e1, kbar = km * e1, abar = av * (e2 * ed), rbar = rx * e2;
                    *(LAS u32x2*)(Pb + P_BK + (s * 72 + kq * 4) * 2) = pack4(bbar);
                    *(LAS u32x2*)(Pb + P_BK + ((16 + s) * 72 + kq * 4) * 2) = pack4(kbar);
                    *(LAS u32x2*)(Pb + P_AR + (s * 72 + kq * 4) * 2) = pack4(abar);
                    *(LAS u32x2*)(Pb + P_AR + ((16 + s) * 72 + kq * 4) * 2) = pack4(rbar);
#pragma unroll
                    for (int i = 0; i < 4; ++i) {
                        *(LAS bf16_t*)(Pb + P_BKT + ((kq * 4 + i) * 40 + s) * 2) = f2bf(bbar[i]);
                        *(LAS bf16_t*)(Pb + P_BKT + ((kq * 4 + i) * 40 + 16 + s) * 2) = f2bf(kbar[i]);
                    }
                    if (s == 15) *(LAS f32x4*)(Pb + P_LAM + kq * 16) = e2;
                }
                if (it + 1 < NCH) SC2_LOAD(it + 1);
                SC2_BAR();
            }
        } else if (wid == 7) {
            const int j = lane >> 2, v8 = (lane & 3) * 8;
            const size_t gv = (tokb + j) * D + h * 64 + half * 32 + v8;
            u32x4 vr = *(const GAS u32x4*)(V + gv);
            const bf16_t* Wl = W + tokb * D + h * 64 + lane;
            bf16_t ewl[16];
#pragma unroll
            for (int i = 0; i < 16; ++i) ewl[i] = Wl[(size_t)(CL + i) * D];
#pragma unroll 1
            for (int it = 0; it < NCH + 2; ++it) {
                if (it < NCH) {
                    LAS unsigned char* vt = lds + L_P + (it % 3) * P_SIZE + P_VT + (v8 * 20 + j) * 2;
                    *(LAS bf16_t*)(vt + 0 * 40) = (bf16_t)(vr.x & 0xffff); *(LAS bf16_t*)(vt + 1 * 40) = (bf16_t)(vr.x >> 16);
                    *(LAS bf16_t*)(vt + 2 * 40) = (bf16_t)(vr.y & 0xffff); *(LAS bf16_t*)(vt + 3 * 40) = (bf16_t)(vr.y >> 16);
                    *(LAS bf16_t*)(vt + 4 * 40) = (bf16_t)(vr.z & 0xffff); *(LAS bf16_t*)(vt + 5 * 40) = (bf16_t)(vr.z >> 16);
                    *(LAS bf16_t*)(vt + 6 * 40) = (bf16_t)(vr.w & 0xffff); *(LAS bf16_t*)(vt + 7 * 40) = (bf16_t)(vr.w >> 16);
                }
                if (it + 1 < NCH) {
                    LAS float* CEn = (LAS float*)(lds + L_CE + ((it + 1) & 1) * 4096);
                    float c = 0.f;
#pragma unroll
                    for (int i = 0; i < 16; ++i) { c += __uint_as_float((unsigned)ewl[i] << 16); CEn[i * 64 + lane] = c; }
                    vr = *(const GAS u32x4*)(V + gv + (size_t)(it + 1) * CL * D);
                }
                if (it + 2 < NCH) {
#pragma unroll
                    for (int i = 0; i < 16; ++i) ewl[i] = Wl[(size_t)((it + 2) * CL + i) * D];
                }
                SC2_BAR();
            }
        } else if (wid == 3) {
            LAS float* MABS = (LAS float*)(lds + L_MAB);
#pragma unroll 1
            for (int it = 0; it < NCH + 2; ++it) {
                if (it >= 1 && it <= NCH) for (int rp_ = 0; rp_ < 1 + (MK_SC2P & 1); ++rp_) {
                    const LAS unsigned char* Pb = lds + L_P + ((it - 1) % 3) * P_SIZE;
                    LAS unsigned char* Qb = lds + L_Q + ((it - 1) & 1) * Q_SIZE;
                    f32x4 mn[2][2];
#pragma unroll
                    for (int jt = 0; jt < 2; ++jt)
#pragma unroll
                        for (int st = 0; st < 2; ++st) {
                            mn[jt][st] = (f32x4){0.f, 0.f, 0.f, 0.f};
#pragma unroll
                            for (int ks = 0; ks < 2; ++ks) {
                                const bf16x8 af = *(const LAS bf16x8*)(Pb + P_BK + ((16 * jt + l15) * 72 + 32 * ks + 8 * q) * 2);
                                const bf16x8 bf = *(const LAS bf16x8*)(Pb + P_AR + ((16 * st + l15) * 72 + 32 * ks + 8 * q) * 2);
                                mn[jt][st] = mfma32(af, bf, mn[jt][st]);
                            }
                        }
#pragma unroll
                    for (int i = 0; i < 4; ++i) {
                        const int j = 4 * q + i;
                        if (!(j < l15)) { mn[0][0][i] = 0.f; mn[1][0][i] = 0.f; }
                        if (!(j <= l15)) { mn[0][1][i] = 0.f; mn[1][1][i] = 0.f; }
                    }
                    *(LAS u32x2*)(Qb + Q_MKB + (l15 * 16 + 4 * q) * 2) = pack4(mn[1][0]);
                    *(LAS u32x2*)(Qb + Q_NBR + (l15 * 16 + 4 * q) * 2) = pack4(mn[0][1]);
                    *(LAS u32x2*)(Qb + Q_NKR + (l15 * 16 + 4 * q) * 2) = pack4(mn[1][1]);
#pragma unroll
                    for (int r = 0; r < 4; ++r) MABS[(4 * q + r) * 16 + l15] = mn[0][0][r];
                    LDS_WAIT(); asm volatile("" ::: "memory");
                    f32x4 MR[15][4];
#pragma unroll
                    for (int i = 0; i < 15; ++i)
#pragma unroll
                        for (int g = 0; g < 4; ++g) if (4 * g + 3 > i) MR[i][g] = *(const LAS f32x4*)(MABS + i * 16 + 4 * g);
                    LDS_WAIT(); asm volatile("" ::: "memory");
                    float Tr[16], Ps[16];
#pragma unroll
                    for (int s2 = 0; s2 < 16; ++s2) Ps[s2] = 0.f;
#pragma unroll
                    for (int i = 0; i < 16; ++i) {
                        const float Ti = ((l15 == i) ? 1.f : 0.f) + Ps[i];
                        Tr[i] = Ti;
                        if (i < 15) {
#pragma unroll
                            for (int s2 = 0; s2 < 16; ++s2) if (s2 > i) Ps[s2] += Ti * MR[i][s2 >> 2][s2 & 3];
                        }
                    }
#pragma unroll
                    for (int s = 0; s < 16; ++s) *(LAS bf16_t*)(Qb + Q_TT + (s * 16 + l15) * 2) = f2bf(Tr[s]);
                }
                SC2_BAR();
            }
        } else {
            LAS unsigned char* S16 = lds + L_S16 + wid * 2304;
            LAS unsigned char* XU = lds + L_XU + wid * 640;
            f32x4 St[4];
#pragma unroll
            for (int kt = 0; kt < 4; ++kt) St[kt] = (f32x4){0.f, 0.f, 0.f, 0.f};
            for (int e = lane; e < 16 * 72 / 2; e += 64) ((LAS unsigned*)S16)[e] = 0u;
            LDS_WAIT();
#pragma unroll 1
            for (int it = 0; it < NCH + 2; ++it) {
                if (it >= 2) {
                    const int c = it - 2;
                    const LAS unsigned char* Pb = lds + L_P + (c % 3) * P_SIZE;
                    const LAS unsigned char* Qb = lds + L_Q + (c & 1) * Q_SIZE;
                    bf16x8 sa[2];
#pragma unroll
                    for (int ks = 0; ks < 2; ++ks) sa[ks] = *(const LAS bf16x8*)(S16 + (l15 * 72 + 32 * ks + 8 * q) * 2);
                    const s16x4 va = *(const LAS s16x4*)(Pb + P_VT + ((16 * wid + l15) * 20 + 4 * q) * 2);
                    f32x4 X = {0.f, 0.f, 0.f, 0.f}, Yc = X;
#pragma unroll
                    for (int ks = 0; ks < 2; ++ks) {
                        X = mfma32(sa[ks], *(const LAS bf16x8*)(Pb + P_AR + (l15 * 72 + 32 * ks + 8 * q) * 2), X);
                        Yc = mfma32(sa[ks], *(const LAS bf16x8*)(Pb + P_AR + ((16 + l15) * 72 + 32 * ks + 8 * q) * 2), Yc);
                    }
                    X = mfma16(va, *(const LAS s16x4*)(Qb + Q_MKB + (l15 * 16 + 4 * q) * 2), X);
                    Yc = mfma16(va, *(const LAS s16x4*)(Qb + Q_NKR + (l15 * 16 + 4 * q) * 2), Yc);
                    MF_SETTLE(X);
#pragma unroll
                    for (int i = 0; i < 4; ++i) *(LAS bf16_t*)(XU + ((4 * q + i) * 20 + l15) * 2) = f2bf(X[i]);
                    LDS_WAIT(); asm volatile("" ::: "memory");
                    const s16x4 xa = *(const LAS s16x4*)(XU + (l15 * 20 + 4 * q) * 2);
                    f32x4 U = mfma16(xa, *(const LAS s16x4*)(Qb + Q_TT + (l15 * 16 + 4 * q) * 2), (f32x4){0.f, 0.f, 0.f, 0.f});
                    LDS_WAIT(); asm volatile("" ::: "memory");
                    MF_SETTLE(U);
#pragma unroll
                    for (int i = 0; i < 4; ++i) *(LAS bf16_t*)(XU + ((4 * q + i) * 20 + l15) * 2) = f2bf(U[i]);
                    LDS_WAIT(); asm volatile("" ::: "memory");
                    const s16x4 ua = *(const LAS s16x4*)(XU + (l15 * 20 + 4 * q) * 2);
                    Yc = mfma16(ua, *(const LAS s16x4*)(Qb + Q_NBR + (l15 * 16 + 4 * q) * 2), Yc);
                    MF_SETTLE(Yc);
                    *(GAS u32x2*)(Y + (tokb + (size_t)c * CL + l15) * D + h * 64 + half * 32 + 16 * wid + 4 * q) = pack4(Yc);
#pragma unroll
                    for (int kt = 0; kt < 4; ++kt) {
                        const float lam = *(const LAS float*)(Pb + P_LAM + (16 * kt + l15) * 4);
                        St[kt] = mfma16(ua, *(const LAS s16x4*)(Pb + P_BKT + ((16 * kt + l15) * 40 + 4 * q) * 2), St[kt]);
                        St[kt] = mfma16(va, *(const LAS s16x4*)(Pb + P_BKT + ((16 * kt + l15) * 40 + 16 + 4 * q) * 2), St[kt]);
                        St[kt] = St[kt] * lam;
                    }
#pragma unroll
                    for (int kt = 0; kt < 4; ++kt)
#pragma unroll
                        for (int i = 0; i < 4; ++i) *(LAS bf16_t*)(S16 + ((4 * q + i) * 72 + 16 * kt + l15) * 2) = f2bf(St[kt][i]);
                    LDS_WAIT(); asm volatile("" ::: "memory");
                }
                SC2_BAR();
            }
        }
    }
}
#if MK_SCAN2
#define SCAN_FN scan_phase2
#else
#define SCAN_FN scan_phase
#endif
struct Params { const float* in[34]; float* out; unsigned char* ws; int lo, hi, coop, pad; };
constexpr int NPHASE = 32;

#define XB_TMO      128
#define XB_XCNT(j)  (256  + 64 * (j))
#define XB_XSUB(j)  (1280 + 64 * (j))
#define XB_XGEN(j)  (2304 + 64 * (j))
#define XB_TOP      3328
#define XB_TOPGEN   3392
#define XCD_BAR_WORDS 3456
#define XB_SPIN_CAP (1u << 20)
__device__ __forceinline__ unsigned xb_ld(unsigned* p)              { return __hip_atomic_load(p, __ATOMIC_RELAXED, __HIP_MEMORY_SCOPE_AGENT); }
__device__ __forceinline__ unsigned xb_add(unsigned* p, unsigned v) { return __hip_atomic_fetch_add(p, v, __ATOMIC_RELAXED, __HIP_MEMORY_SCOPE_AGENT); }
__device__ __forceinline__ unsigned xb_xcc_id() { return (unsigned)__builtin_amdgcn_s_getreg((3 << 11) | 20) & 0xFu; }
#define XB_SPIN(cond, bar) do { unsigned _sp = 0; while (cond) { __builtin_amdgcn_s_sleep(1); \
    if ((++_sp & 255u) == 0u) { if (xb_ld(&(bar)[XB_TMO])) break; if (_sp > XB_SPIN_CAP) { atomicAdd(&(bar)[XB_TMO], 1u); break; } } } } while (0)
__device__ __forceinline__ void xcd_barrier_complete(unsigned* bar, unsigned x, unsigned& nloc, unsigned& nx) {
    const unsigned G = gridDim.x * gridDim.y * gridDim.z;
    unsigned sum, cnt, mine, sp = 0u;
    for (;;) {
        sum = 0u; cnt = 0u; mine = 0u;
#pragma unroll
        for (unsigned j = 0; j < 16; ++j) { const unsigned c = xb_ld(&bar[XB_XCNT(j)]); sum += c; cnt += (c > 0u) ? 1u : 0u; mine = (j == x) ? c : mine; }
        if (sum == G) break;
        __builtin_amdgcn_s_sleep(1);
        if ((++sp & 255u) == 0u) { if (xb_ld(&bar[XB_TMO])) break; if (sp > XB_SPIN_CAP) { atomicAdd(&bar[XB_TMO], 1u); break; } }
    }
    nloc = mine > 0u ? mine : 1u; nx = cnt > 0u ? cnt : 1u;
}
__device__ __forceinline__ void grid_barrier(unsigned* bar, volatile LAS unsigned* st, int wid) {
    asm volatile("s_waitcnt vmcnt(0)" ::: "memory");
    __syncthreads();
    if (wid == 0) {
        if (lane_id() == 0) {
            const unsigned x = xb_xcc_id();
            __builtin_amdgcn_s_waitcnt(0);
            unsigned nloc = st[0], nx = st[1];
            if (nloc == 0u) { xcd_barrier_complete(bar, x, nloc, nx); st[0] = nloc; st[1] = nx; }
            const unsigned old = xb_add(&bar[XB_XSUB(x)], 1u);
            const unsigned gen = old / nloc;
            if (old + 1u == (gen + 1u) * nloc) {
                __builtin_amdgcn_fence(__ATOMIC_RELEASE, "agent");
                asm volatile("s_waitcnt vmcnt(0)" ::: "memory");
                const unsigned og = xb_add(&bar[XB_TOP], 1u);
                const unsigned tg = og / nx;
                if (og + 1u == (tg + 1u) * nx) xb_add(&bar[XB_TOPGEN], 1u);
                else XB_SPIN(xb_ld(&bar[XB_TOPGEN]) == tg, bar);
                __builtin_amdgcn_fence(__ATOMIC_ACQUIRE, "agent");
                xb_add(&bar[XB_XGEN(x)], 1u);
                asm volatile("s_waitcnt vmcnt(0)" ::: "memory");
            } else {
                XB_SPIN(xb_ld(&bar[XB_XGEN(x)]) == gen, bar);
                __builtin_amdgcn_fence(__ATOMIC_ACQUIRE, "agent");
                asm volatile("s_waitcnt vmcnt(0)" ::: "memory");
            }
        }
    }
    __syncthreads();
}

__global__ void __launch_bounds__(512, 2) mk_fwd(Params p) {
    extern __shared__ __attribute__((aligned(16))) unsigned char lds_raw[];
    LAS unsigned char* lds = (LAS unsigned char*)lds_raw;
    if (p.coop) cg::this_grid().sync();
    LAS unsigned* PL = (LAS unsigned*)(lds + 131072);
    int wid_s = __builtin_amdgcn_readfirstlane((int)threadIdx.x >> 6);
    if (threadIdx.x < 36) { const unsigned long long v = threadIdx.x < 34 ? (unsigned long long)p.in[threadIdx.x] : (threadIdx.x == 34 ? (unsigned long long)p.out : (unsigned long long)p.ws);
        PL[2 * threadIdx.x] = (unsigned)v; PL[2 * threadIdx.x + 1] = (unsigned)(v >> 32); }
    volatile LAS unsigned* BST = (volatile LAS unsigned*)(lds + 131072 + 512);
    if (threadIdx.x == 64) { BST[0] = 0u; BST[1] = 0u; }
    if (threadIdx.x == 0 && p.hi - p.lo > 1) (void)xb_add((unsigned*)(p.ws + WS_CTL) + XB_XCNT(xb_xcc_id()), 1u);
    __syncthreads();
#define PIN(i) ldp(PL, (i))
    const int ph_lo = p.lo, ph_hi = p.hi;
#define WSP ((unsigned char*)PIN(35))
#define OUT ((float*)PIN(34))
#define LF ((float*)(WSP + WS_LF))
#define BON ((float*)(WSP + WS_BON))
#define HB ((bf16_t*)(WSP + WS_HB))
#define VF ((bf16_t*)OUT)
#define XB ((bf16_t*)(WSP + WS_VF))
#define PROJ ((bf16_t*)(WSP + WS_BIG))
#define ACT ((bf16_t*)(WSP + WS_BIG))
#define RB ((bf16_t*)(WSP + WS_R))
#define KB_ ((bf16_t*)(WSP + WS_K))
#define VB_ ((bf16_t*)(WSP + WS_V))
#define WBUF ((bf16_t*)(WSP + WS_W))
#define AB ((bf16_t*)(WSP + WS_A))
#define LM ((bf16_t*)(WSP + WS_LM))
#define WB (WSP + WS_WB)
    constexpr int BIGK = 1 << 30;
#define PH_BEGIN(X, KIND) if (ph_lo <= (X) && (X) < ph_hi) { _Pragma("unroll 1") for (int rep_ = 0; rep_ < 1 + ((MK_DOUBLE >> (KIND)) & 1); ++rep_) { const int wid = wid_s, lane = lane_id(), tid = wid * 64 + lane; const int gw = (int)blockIdx.x * 8 + wid, NGW = (int)gridDim.x * 8; LAS float* scr = (LAS float*)(lds + wid * 8448); (void)tid; (void)gw; (void)NGW; (void)scr; (void)lane;
#define PH_END(X) } if ((X) + 1 < ph_hi) { grid_barrier((unsigned*)(WSP + WS_CTL), (volatile LAS unsigned*)(lds + 131072 + 512), wid_s); if (MK_BAR2) grid_barrier((unsigned*)(WSP + WS_CTL), (volatile LAS unsigned*)(lds + 131072 + 512), wid_s); } asm volatile("" : "+s"(wid_s)); }
#define FFN_PHASES(layer, P0) \
    PH_BEGIN(P0, 0) \
        prep_ffn(PIN(3) + (size_t)(layer) * D * F, PIN(4) + (size_t)(layer) * D * F, PIN(5) + (size_t)(layer) * F * D, (bf16_t*)(WB + WB_WGU), (bf16_t*)(WB + WB_WD), gw, NGW, scr, lane); \
        rmsnorm_rows<0, true>(XB, PIN(2) + (layer) * D, HB, gw, NGW, lane, nullptr, nullptr, nullptr); \
    PH_END(P0) \
    PH_BEGIN(P0 + 1, 3) \
        const Gemm g{HB, (const bf16_t*)(WB + WB_WGU), T, 2 * F, D, D, D, 0, BIGK, 0, 0, 31, 0}; \
        gemm_phase(lds, wid, g, EpiSwiglu{ACT}); \
    PH_END(P0 + 1) \
    PH_BEGIN(P0 + 2, 5) \
        const Gemm g{ACT, (const bf16_t*)(WB + WB_WD), T, D, F, F, F, 0, BIGK, 0, 0, 31, 0}; \
        gemm_phase(lds, wid, g, EpiRes<false, (layer) == 3>{XB, (layer) == 3 ? (void*)OUT : (void*)XB}); \
    PH_END(P0 + 2)
#define HYBRID_PHASES(layer, idx, P0) \
    PH_BEGIN(P0, 0) \
        const float* w_in = PIN(6) + (size_t)(idx) * D * INC; \
        LAS float* WF = (LAS float*)(lds + 98304); \
        for (int k = tid; k < D; k += 512) { const f32x4 a = *(const f32x4*)(w_in + (size_t)k * INC + 2048), b = *(const f32x4*)(w_in + (size_t)k * INC + 2052); \
            *(LAS f32x4*)(WF + k * 8) = a; *(LAS f32x4*)(WF + k * 8 + 4) = b; } \
        __syncthreads(); \
        prep_hybrid(w_in, PIN(12) + (size_t)(idx) * D * D, PIN(10) + (size_t)(idx) * 4 * 128 * 128, PIN(11) + (idx) * 512, (bf16_t*)(WB + WB_WIN), (bf16_t*)(WB + WB_WOUT), gw, NGW, scr, lane); \
        rmsnorm_rows<1, (layer) != 0>((layer) == 0 ? (const void*)PIN(0) : (const void*)XB, PIN(1) + (layer) * D, HB, gw, NGW, lane, WF, PIN(7) + (idx) * 8, LF); \
    PH_END(P0) \
    PH_BEGIN(P0 + 1, 1) \
        const Gemm g{HB, (const bf16_t*)(WB + WB_WIN), T, NPROJ, D, D, D, 0, BIGK, 0, 0, 31, 0}; \
        gemm_phase(lds, wid, g, EpiHybIn{PROJ, PIN(8) + (idx) * 64, PIN(9) + (idx) * 64}); \
    PH_END(P0 + 1) \
    PH_BEGIN(P0 + 2, 2) \
        attn_phase(lds, wid, PROJ, LF, HB, PIN(8) + (idx) * 64, PIN(9) + (idx) * 64); \
    PH_END(P0 + 2) \
    PH_BEGIN(P0 + 3, 8) \
        const Gemm g{HB, (const bf16_t*)(WB + WB_WOUT), T, D, D, D, D, 0, BIGK, 0, 0, 31, 0}; \
        gemm_phase(lds, wid, g, EpiRes<(layer) == 0, false>{(layer) == 0 ? (const void*)PIN(0) : (const void*)XB, XB}); \
    PH_END(P0 + 3) \
    FFN_PHASES(layer, P0 + 4)
#define RWKV_PHASES(layer, idx, P0) \
    PH_BEGIN(P0, 0) \
        prep_rwkv(PL, idx, (bf16_t*)(WB + WB_WR2), (bf16_t*)(WB + WB_WR3), (bf16_t*)(WB + WB_WG), (bf16_t*)(WB + WB_WO), gw, NGW, scr, lane); \
        rmsnorm_rows_rwkv(XB, PIN(1) + (layer) * D, PIN(13) + (size_t)(idx) * 6 * D, PIN(13) + (size_t)(idx) * 6 * D + 2 * D, HB, WBUF, AB, gw, NGW, lane); \
    PH_END(P0) \
    PH_BEGIN(P0 + 1, 4) \
        {     \
            const Gemm g{WBUF, (const bf16_t*)(WB + WB_WR2), T, 2048, D, D, D, 0, BIGK, 0, 0, 2, (size_t)(WS_A - WS_W)}; \
            gemm_phase(lds, wid, g, EpiRwkvIn{RB, (long)((WS_K - WS_R) / 2), 0L, LM, 0}); \
        } \
        {     \
            const Gemm g{HB, (const bf16_t*)(WB + WB_WR2 + (size_t)2048 * 1024 * 2), T, 1536, 2048, D, 2048, 1, 16, 2048, -2048, 31, 0}; \
            gemm_phase(lds, wid, g, EpiRwkvIn{RB, (long)((WS_K - WS_R) / 2), (idx) == 0 ? (long)(VF - RB) : (long)((WS_V - WS_R) / 2), LM, 8}); \
        } \
    PH_END(P0 + 1) \
    PH_BEGIN(P0 + 2, 15) \
        const Gemm g{LM, (const bf16_t*)(WB + WB_WR3), T, (idx) > 0 ? 3072 : 2048, 384, 512, 384, 0, BIGK, 0, 0, 31, 0}; \
        gemm_phase(lds, wid, g, EpiLoraUp{WBUF, VF, PL, idx}); \
    PH_END(P0 + 2) \
    PH_BEGIN(P0 + 3, 6) \
        SCAN_FN(lds, wid, RB, KB_, ((idx) == 0 ? VF : VB_), WBUF, AB, PIN(25) + (idx) * D, PIN(26) + (idx) * D, PIN(27) + (idx) * D, HB, BON); \
    PH_END(P0 + 3) \
    PH_BEGIN(P0 + 4, 7) \
        const Gemm g{LM + 128, (const bf16_t*)(WB + WB_WG), T, D, 256, 512, 256, 0, BIGK, 0, 0, 31, 0}; \
        gemm_phase(lds, wid, g, EpiGPost{HB, ((idx) == 0 ? VF : VB_), BON, PIN(28) + (idx) * D, PIN(29) + (idx) * D, WBUF}); \
    PH_END(P0 + 4) \
    PH_BEGIN(P0 + 5, 9) \
        const Gemm g{WBUF, (const bf16_t*)(WB + WB_WO), T, D, D, D, D, 0, BIGK, 0, 0, 31, 0}; \
        gemm_phase(lds, wid, g, EpiRes<false, false>{XB, XB}); \
    PH_END(P0 + 5) \
    FFN_PHASES(layer, P0 + 6)

    HYBRID_PHASES(0, 0, 0)
    RWKV_PHASES(1, 0, 7)
    HYBRID_PHASES(2, 1, 16)
    RWKV_PHASES(3, 1, 23)
}
}

extern "C" void kernel_launch(void* const* d_in, const int* in_sizes, int n_in, void* d_out, int out_size, void* d_ws, size_t ws_size,
                              hipStream_t stream) {
    static int grid = 0;
    if (grid == 0) {
        if (n_in != 34 || ws_size < mk::WS_END) { fprintf(stderr, "kernel_launch: unexpected n_in %d / ws_size %zu (need %zu)\n", n_in, ws_size, (size_t)mk::WS_END); grid = -1; return; }
        int dev = 0, cus = 0, per_cu = 0;
        (void)hipGetDevice(&dev); (void)hipDeviceGetAttribute(&cus, hipDeviceAttributeMultiprocessorCount, dev);
        if (hipFuncSetAttribute((const void*)mk::mk_fwd, hipFuncAttributeMaxDynamicSharedMemorySize, mk::LDS_BYTES) != hipSuccess) { fprintf(stderr, "kernel_launch: hipFuncSetAttribute failed\n"); grid = -1; return; }
        if (hipOccupancyMaxActiveBlocksPerMultiprocessor(&per_cu, (const void*)mk::mk_fwd, 512, mk::LDS_BYTES) != hipSuccess || per_cu < 1) { fprintf(stderr, "kernel_launch: occupancy query says %d\n", per_cu); per_cu = 1; }
        (void)hipGetLastError();
        grid = cus * 1;
        if (grid <= 0) grid = 256;
    }
    if (grid < 0) return;
    mk::Params p{};
    for (int i = 0; i < 34; ++i) p.in[i] = (const float*)d_in[i];
    p.out = (float*)d_out; p.ws = (unsigned char*)d_ws;
#if MK_CUT > 0
    (void)hipMemsetAsync((char*)d_ws + mk::WS_CTL, 0, 16384, stream);
#if MK_SPLIT
    for (int ph = 0; ph < MK_CUT; ++ph) { p.lo = ph; p.hi = ph + 1; hipLaunchKernelGGL(mk::mk_fwd, dim3(grid), dim3(512), mk::LDS_BYTES, stream, p); }
#else
    p.lo = 0; p.hi = MK_CUT; p.coop = 1;
    void* args[] = {&p};
    hipError_t e = hipLaunchCooperativeKernel((const void*)mk::mk_fwd, dim3(grid), dim3(512), args, mk::LDS_BYTES, stream);
    if (e != hipSuccess) fprintf(stderr, "cooperative launch failed: %s (grid %d)\n", hipGetErrorString(e), grid);
#endif
#endif
#if MK_CUT < 32
    nv::run_from(d_in, (float*)d_out, (unsigned char*)d_ws, MK_CUT, stream);
#endif
}
```

```cpp
#include <hip/hip_runtime.h>
#include <hip/hip_cooperative_groups.h>
#include <cstdint>
#include <cstdio>
namespace cg = cooperative_groups;
#ifndef MK_CUT
#define MK_CUT 32
#endif
#ifndef MK_DOUBLE
#define MK_DOUBLE 0
#endif
#ifndef MK_SCAN2
#define MK_SCAN2 1
#endif
#ifndef MK_SC2P
#define MK_SC2P 0
#endif
#ifndef MK_BAR2
#define MK_BAR2 0
#endif
#ifndef MK_SPLIT
#define MK_SPLIT 0
#endif
#if MK_CUT < 32
namespace nv {
constexpr int D = 1024, S = 4096, NB = 8, F = 2816, INC = 2568;

__device__ __forceinline__ float softplusf(float x) { return fmaxf(x, 0.f) + log1pf(expf(-fabsf(x))); }
__device__ __forceinline__ float sigmoidf(float x) { return 1.f / (1.f + expf(-x)); }

__global__ __launch_bounds__(256) void rmsnorm(const float* __restrict__ x, const float* __restrict__ gain, float* __restrict__ out) {
    __shared__ float red[4];
    const size_t row = blockIdx.x;
    const float4 v = *(const float4*)(x + row * D + threadIdx.x * 4);
    float s = v.x * v.x + v.y * v.y + v.z * v.z + v.w * v.w;
    for (int o = 32; o > 0; o >>= 1) s += __shfl_xor(s, o);
    if ((threadIdx.x & 63) == 0) red[threadIdx.x >> 6] = s;
    __syncthreads();
    s = red[0] + red[1] + red[2] + red[3];
    const float r = rsqrtf(s * (1.f / D) + 1e-6f);
    const float4 g = *(const float4*)(gain + threadIdx.x * 4);
    float4 o4; o4.x = v.x * r * g.x; o4.y = v.y * r * g.y; o4.z = v.z * r * g.z; o4.w = v.w * r * g.w;
    *(float4*)(out + row * D + threadIdx.x * 4) = o4;
}

__global__ __launch_bounds__(256) void gemm(const float* __restrict__ A, int lda, const float* __restrict__ B, int ldb,
                                            float* __restrict__ C, int ldc, int M, int N, int K, int accum,
                                            const float* __restrict__ mu) {
    __shared__ float sA[16][65];
    __shared__ float sB[16][64];
    const int tx = threadIdx.x & 15, ty = threadIdx.x >> 4;
    const int m0 = blockIdx.y * 64, n0 = blockIdx.x * 64;
    float c[4][4];
#pragma unroll
    for (int i = 0; i < 4; ++i)
#pragma unroll
        for (int j = 0; j < 4; ++j) c[i][j] = 0.f;
    for (int k0 = 0; k0 < K; k0 += 16) {
        for (int i = threadIdx.x; i < 1024; i += 256) {
            const int m = i >> 4, k = i & 15; const int row = m0 + m;
            float v = A[(size_t)row * lda + k0 + k];
            if (mu) { const float p = row > 0 ? A[(size_t)(row - 1) * lda + k0 + k] : 0.f; v = v + (p - v) * mu[k0 + k]; }
            sA[k][m] = v;
        }
        for (int i = threadIdx.x; i < 1024; i += 256) {
            const int k = i >> 6, n = i & 63;
            sB[k][n] = (n0 + n < N) ? B[(size_t)(k0 + k) * ldb + n0 + n] : 0.f;
        }
        __syncthreads();
#pragma unroll
        for (int k = 0; k < 16; ++k) {
            float a[4], b[4];
#pragma unroll
            for (int i = 0; i < 4; ++i) { a[i] = sA[k][ty * 4 + i]; b[i] = sB[k][tx * 4 + i]; }
#pragma unroll
            for (int i = 0; i < 4; ++i)
#pragma unroll
                for (int j = 0; j < 4; ++j) c[i][j] += a[i] * b[j];
        }
        __syncthreads();
    }
#pragma unroll
    for (int i = 0; i < 4; ++i)
#pragma unroll
        for (int j = 0; j < 4; ++j) {
            const int n = n0 + tx * 4 + j; const int m = m0 + ty * 4 + i;
            if (n < N) { float* p = C + (size_t)m * ldc + n; *p = accum ? (*p + c[i][j]) : c[i][j]; }
        }
}

__global__ void qknorm(float* __restrict__ P, const float* __restrict__ qg, const float* __restrict__ kg) {
    const int idx = blockIdx.x * blockDim.x + threadIdx.x; if (idx >= S * 16) return;
    const int t = idx >> 4, j = idx & 15;
    float* p = P + (size_t)t * INC + j * 64; const float* g = j < 8 ? qg : kg;
    float s = 0.f; for (int d = 0; d < 64; ++d) s += p[d] * p[d];
    const float r = rsqrtf(s * (1.f / 64.f) + 1e-6f);
    for (int d = 0; d < 64; ++d) p[d] = p[d] * r * g[d];
}
__global__ void cumk(const float* __restrict__ P, const float* __restrict__ fb, float* __restrict__ cum) {
    const int h = threadIdx.x; if (h >= 8) return;
    float c = 0.f;
    for (int t = 0; t < S; ++t) { const float z = P[(size_t)t * INC + 2048 + h] + fb[h]; c += -softplusf(-z); cum[h * S + t] = c; }
}
__global__ __launch_bounds__(64) void attn(const float* __restrict__ P, const float* __restrict__ cum, float* __restrict__ cat) {
    __shared__ float Ks[64][64];
    __shared__ float Vs[64][64];
    __shared__ float Cs[64];
    const int h = blockIdx.y, qb = blockIdx.x, tid = threadIdx.x, t = qb * 64 + tid;
    float q[64], o[64];
#pragma unroll
    for (int d = 0; d < 64; ++d) { q[d] = P[(size_t)t * INC + h * 64 + d] * 0.125f; o[d] = 0.f; }
    const float ct = cum[h * S + t];
    float m = -1e30f, l = 0.f;
    for (int kt = 0; kt <= qb; ++kt) {
        __syncthreads();
        for (int r = 0; r < 64; ++r) {
            Ks[r][tid] = P[(size_t)(kt * 64 + r) * INC + 512 + h * 64 + tid];
            Vs[r][tid] = P[(size_t)(kt * 64 + r) * INC + 1024 + h * 64 + tid];
        }
        Cs[tid] = cum[h * S + kt * 64 + tid];
        __syncthreads();
        for (int j = 0; j < 64; ++j) {
            const int s = kt * 64 + j;
            if (s <= t) {
                float dot = 0.f;
#pragma unroll
                for (int d = 0; d < 64; ++d) dot += q[d] * Ks[j][d];
                const float lg = dot + ct - Cs[j];
                const float mn = fmaxf(m, lg); const float corr = expf(m - mn); const float p = expf(lg - mn);
                l = l * corr + p; m = mn;
#pragma unroll
                for (int d = 0; d < 64; ++d) o[d] = o[d] * corr + p * Vs[j][d];
            }
        }
    }
    const float inv = 1.f / l;
#pragma unroll
    for (int d = 0; d < 64; ++d) {
        const float og = P[(size_t)t * INC + 1536 + h * 64 + d];
        cat[(size_t)t * D + h * 64 + d] = o[d] * inv * sigmoidf(og);
    }
}
__global__ void pool(const float* __restrict__ P, float* __restrict__ tmp) {
    const int idx = blockIdx.x * blockDim.x + threadIdx.x; if (idx >= S * 512) return;
    const int t = idx >> 9, c = idx & 511, g = c >> 7; const int w = 2 << g;
    const int cnt = min(t + 1, w); float s = 0.f;
    for (int j = 0; j < cnt; ++j) s += P[(size_t)(t - j) * INC + 2056 + c];
    tmp[idx] = s / (float)cnt - P[(size_t)t * INC + 2056 + c];
}
__global__ void scale_cols(float* __restrict__ cat, const float* __restrict__ sc) {
    const int idx = blockIdx.x * blockDim.x + threadIdx.x; if (idx >= S * 512) return;
    const int t = idx >> 9, c = idx & 511; cat[(size_t)t * D + 512 + c] *= sc[c];
}
__global__ void swiglu(float* __restrict__ G, const float* __restrict__ U, int n) {
    const int idx = blockIdx.x * blockDim.x + threadIdx.x; if (idx >= n) return;
    const float g = G[idx]; G[idx] = g * sigmoidf(g) * U[idx];
}
__global__ void act_tanh(float* __restrict__ p, int n) { const int i = blockIdx.x * blockDim.x + threadIdx.x; if (i < n) p[i] = tanhf(p[i]); }
__global__ void act_sig(float* __restrict__ p, int n) { const int i = blockIdx.x * blockDim.x + threadIdx.x; if (i < n) p[i] = sigmoidf(p[i]); }
__global__ void add_bias_cols(float* __restrict__ p, const float* __restrict__ b, int n) {
    const int i = blockIdx.x * blockDim.x + threadIdx.x; if (i < n) p[i] += b[i & 1023];
}
__global__ void vmix(float* __restrict__ v, const float* __restrict__ vf, const float* __restrict__ gate, int n) {
    const int i = blockIdx.x * blockDim.x + threadIdx.x; if (i < n) { const float x = v[i]; v[i] = x + (vf[i] - x) * sigmoidf(gate[i]); }
}
__global__ void copyk(float* __restrict__ d, const float* __restrict__ s, int n) { const int i = blockIdx.x * blockDim.x + threadIdx.x; if (i < n) d[i] = s[i]; }
__global__ void rwkv_prep(float* __restrict__ k, float* __restrict__ w, float* __restrict__ a, float* __restrict__ aa,
                          const float* __restrict__ k_k, const float* __restrict__ k_a) {
    const int idx = blockIdx.x * blockDim.x + threadIdx.x; if (idx >= S * 16) return;
    const int t = idx >> 4, h = idx & 15; const size_t o = (size_t)t * D + h * 64;
    float s = 0.f;
    for (int d = 0; d < 64; ++d) { const float x = k[o + d] * k_k[h * 64 + d]; s += x * x; }
    const float inv = 1.f / fmaxf(sqrtf(s), 1e-12f);
    for (int d = 0; d < 64; ++d) {
        const float kv = k[o + d]; const float kk = kv * k_k[h * 64 + d] * inv; const float av = sigmoidf(a[o + d]);
        const float wl = -softplusf(-w[o + d]) - 0.5f;
        w[o + d] = expf(-expf(wl));
        k[o + d] = kv * (1.f + (av - 1.f) * k_a[h * 64 + d]);
        a[o + d] = kk * av; aa[o + d] = -kk;
    }
}
__global__ __launch_bounds__(64) void scan(const float* __restrict__ r, const float* __restrict__ w, const float* __restrict__ k, const float* __restrict__ v,
                                           const float* __restrict__ aa, const float* __restrict__ bb, float* __restrict__ y) {
    __shared__ float sr[64], sw[64], sk[64], sa[64], sb[64];
    const int h = blockIdx.x, row = threadIdx.x;
    float st[64];
#pragma unroll
    for (int i = 0; i < 64; ++i) st[i] = 0.f;
    for (int t = 0; t < S; ++t) {
        const size_t o = (size_t)t * D + h * 64;
        __syncthreads();
        sr[row] = r[o + row]; sw[row] = w[o + row]; sk[row] = k[o + row]; sa[row] = aa[o + row]; sb[row] = bb[o + row];
        const float vv = v[o + row];
        __syncthreads();
        float dot = 0.f;
#pragma unroll
        for (int i = 0; i < 64; ++i) dot += st[i] * sa[i];
        float yo = 0.f;
#pragma unroll
        for (int i = 0; i < 64; ++i) { st[i] = st[i] * sw[i] + dot * sb[i] + vv * sk[i]; yo += st[i] * sr[i]; }
        y[o + row] = yo;
    }
}
__global__ void rwkv_post(float* __restrict__ y, const float* __restrict__ r, const float* __restrict__ k, const float* __restrict__ v, const float* __restrict__ g,
                          const float* __restrict__ r_k, const float* __restrict__ ln_w, const float* __restrict__ ln_b) {
    const int idx = blockIdx.x * blockDim.x + threadIdx.x; if (idx >= S * 16) return;
    const int t = idx >> 4, h = idx & 15; const size_t o = (size_t)t * D + h * 64;
    float mean = 0.f; for (int d = 0; d < 64; ++d) mean += y[o + d]; mean *= (1.f / 64.f);
    float var = 0.f; for (int d = 0; d < 64; ++d) { const float x = y[o + d] - mean; var += x * x; } var *= (1.f / 64.f);
    const float rs = rsqrtf(var + 64e-5f);
    float bs = 0.f; for (int d = 0; d < 64; ++d) bs += r[o + d] * k[o + d] * r_k[h * 64 + d];
    for (int d = 0; d < 64; ++d) {
        const float yn = (y[o + d] - mean) * rs * ln_w[h * 64 + d] + ln_b[h * 64 + d];
        y[o + d] = (yn + bs * v[o + d]) * g[o + d];
    }
}
static inline dim3 g1(int n) { return dim3((n + 255) / 256); }

__global__ void bf2f(const unsigned short* __restrict__ s, float* __restrict__ d, int n) { const int i = blockIdx.x * blockDim.x + threadIdx.x; if (i < n) d[i] = __uint_as_float((unsigned)s[i] << 16); }
static void run_from(void* const* d_in, float* X, unsigned char* wsb, int cut, hipStream_t stream) {
    const float* const* in = (const float* const*)d_in;
    if (cut == 0) (void)hipMemcpyAsync(X, in[0], (size_t)NB * S * D * 4, hipMemcpyDeviceToDevice, stream);
    float* ws = (float*)(wsb + ((size_t)152 << 20));
    const int start_layer = cut == 0 ? 0 : cut == 4 ? 0 : cut == 7 ? 1 : cut == 13 ? 1 : cut == 16 ? 2 : cut == 20 ? 2 : cut == 23 ? 3 : 3;
    const int start_ffn = (cut == 4 || cut == 13 || cut == 20 || cut == 29) ? 1 : 0;
    if (cut >= 13) hipLaunchKernelGGL(bf2f, dim3((NB * S * D + 255) / 256), dim3(256), 0, stream, (const unsigned short*)(wsb + ((size_t)88 << 20)), ws, NB * S * D);
    const size_t SD = (size_t)S * D;
    float* VF = ws;
    float* H = VF + NB * SD;
    float* B0 = H + SD;
    auto GEMM = [&](const float* A, int lda, const float* B, int ldb, float* C, int ldc, int M, int N, int K, int acc, const float* mu) {
        hipLaunchKernelGGL(gemm, dim3((N + 63) / 64, M / 64), dim3(256), 0, stream, A, lda, B, ldb, C, ldc, M, N, K, acc, mu);
    };
    for (int layer = start_layer; layer < 4; ++layer) {
        for (int b = 0; b < NB; ++b) {
            float* xb = X + b * SD;
            const bool do_mixer = !(layer == start_layer && start_ffn);
            if (do_mixer) hipLaunchKernelGGL(rmsnorm, dim3(S), dim3(256), 0, stream, xb, in[1] + layer * D, H);
            if (!do_mixer) {
            } else if (layer % 2 == 0) {
                const int e = layer / 2;
                float* P = B0;
                float* CAT = P + (size_t)S * INC;
                float* TMP = CAT + SD;
                float* CUM = TMP + (size_t)S * 512;
                GEMM(H, D, in[6] + (size_t)e * D * INC, INC, P, INC, S, INC, D, 0, nullptr);
                hipLaunchKernelGGL(qknorm, g1(S * 16), dim3(256), 0, stream, P, in[8] + e * 64, in[9] + e * 64);
                hipLaunchKernelGGL(cumk, dim3(1), dim3(64), 0, stream, P, in[7] + e * 8, CUM);
                hipLaunchKernelGGL(attn, dim3(S / 64, 8), dim3(64), 0, stream, P, CUM, CAT);
                hipLaunchKernelGGL(pool, g1(S * 512), dim3(256), 0, stream, P, TMP);
                for (int g = 0; g < 4; ++g)
                    GEMM(TMP + g * 128, 512, in[10] + ((size_t)e * 4 + g) * 128 * 128, 128, CAT + 512 + g * 128, D, S, 128, 128, 0, nullptr);
                hipLaunchKernelGGL(scale_cols, g1(S * 512), dim3(256), 0, stream, CAT, in[11] + e * 512);
                GEMM(CAT, D, in[12] + (size_t)e * D * D, D, xb, D, S, D, D, 1, nullptr);
            } else {
                const int o = layer / 2;
                float* R = B0; float* K_ = R + SD; float* V = K_ + SD; float* W = V + SD; float* A_ = W + SD; float* G = A_ + SD; float* AA = G + SD; float* Y = AA + SD;
                float* MW = Y + SD; float* MA = MW + (size_t)S * 64; float* MG = MA + (size_t)S * 64; float* MV = MG + (size_t)S * 160;
                const float* mu = in[13] + (size_t)o * 6 * D;
                GEMM(H, D, in[14] + (size_t)o * D * D, D, R, D, S, D, D, 0, mu + 0 * D);
                GEMM(H, D, in[15] + (size_t)o * D * D, D, K_, D, S, D, D, 0, mu + 2 * D);
                GEMM(H, D, in[16] + (size_t)o * D * D, D, V, D, S, D, D, 0, mu + 3 * D);
                GEMM(H, D, in[18] + (size_t)o * D * 64, 64, MW, 64, S, 64, D, 0, mu + 1 * D);
                hipLaunchKernelGGL(act_tanh, g1(S * 64), dim3(256), 0, stream, MW, S * 64);
                GEMM(MW, 64, in[19] + (size_t)o * 64 * D, D, W, D, S, D, 64, 0, nullptr);
                hipLaunchKernelGGL(add_bias_cols, g1(S * D), dim3(256), 0, stream, W, in[17] + o * D, S * D);
                GEMM(H, D, in[21] + (size_t)o * D * 64, 64, MA, 64, S, 64, D, 0, mu + 4 * D);
                GEMM(MA, 64, in[22] + (size_t)o * 64 * D, D, A_, D, S, D, 64, 0, nullptr);
                hipLaunchKernelGGL(add_bias_cols, g1(S * D), dim3(256), 0, stream, A_, in[20] + o * D, S * D);
                GEMM(H, D, in[23] + (size_t)o * D * 160, 160, MG, 160, S, 160, D, 0, mu + 5 * D);
                hipLaunchKernelGGL(act_sig, g1(S * 160), dim3(256), 0, stream, MG, S * 160);
                GEMM(MG, 160, in[24] + (size_t)o * 160 * D, D, G, D, S, D, 160, 0, nullptr);
                if (o == 0) {
                    hipLaunchKernelGGL(copyk, g1(S * D), dim3(256), 0, stream, VF + b * SD, V, S * D);
                } else {
                    GEMM(H, D, in[32] + (size_t)(o - 1) * D * 32, 32, MV, 32, S, 32, D, 0, mu + 3 * D);
                    GEMM(MV, 32, in[33] + (size_t)(o - 1) * 32 * D, D, Y, D, S, D, 32, 0, nullptr);
                    hipLaunchKernelGGL(add_bias_cols, g1(S * D), dim3(256), 0, stream, Y, in[31] + (o - 1) * D, S * D);
                    hipLaunchKernelGGL(vmix, g1(S * D), dim3(256), 0, stream, V, VF + b * SD, Y, S * D);
                }
                hipLaunchKernelGGL(rwkv_prep, g1(S * 16), dim3(256), 0, stream, K_, W, A_, AA, in[25] + o * D, in[26] + o * D);
                hipLaunchKernelGGL(scan, dim3(16), dim3(64), 0, stream, R, W, K_, V, AA, A_, Y);
                hipLaunchKernelGGL(rwkv_post, g1(S * 16), dim3(256), 0, stream, Y, R, K_, V, G, in[27] + o * D, in[28] + o * D, in[29] + o * D);
                GEMM(Y, D, in[30] + (size_t)o * D * D, D, xb, D, S, D, D, 1, nullptr);
            }
            float* G = B0; float* U = G + (size_t)S * F;
            hipLaunchKernelGGL(rmsnorm, dim3(S), dim3(256), 0, stream, xb, in[2] + layer * D, H);
            GEMM(H, D, in[3] + (size_t)layer * D * F, F, G, F, S, F, D, 0, nullptr);
            GEMM(H, D, in[4] + (size_t)layer * D * F, F, U, F, S, F, D, 0, nullptr);
            hipLaunchKernelGGL(swiglu, g1(S * F), dim3(256), 0, stream, G, U, S * F);
            GEMM(G, F, in[5] + (size_t)layer * F * D, D, xb, D, S, D, F, 1, nullptr);
        }
    }
}
}
#endif
namespace mk {
#define LAS __attribute__((address_space(3)))
#define GAS __attribute__((address_space(1)))
typedef unsigned short bf16_t;
typedef short bf16x8 __attribute__((ext_vector_type(8)));
typedef short s16x4 __attribute__((ext_vector_type(4)));
typedef float f32x4 __attribute__((ext_vector_type(4)));
typedef float f32x2 __attribute__((ext_vector_type(2)));
typedef float f32x16 __attribute__((ext_vector_type(16)));
typedef unsigned u32x4 __attribute__((ext_vector_type(4)));
typedef unsigned u32x2 __attribute__((ext_vector_type(2)));

constexpr int T = 32768, S = 4096, D = 1024, F = 2816, INC = 2568, NPROJ = 2560;
constexpr float LOG2E = 1.4426950408889634f;
constexpr float QSCALE = 0.125f * LOG2E;
constexpr size_t MiB = 1u << 20;
constexpr size_t WS_LF = 0, WS_BON = 1 * MiB, WS_WB = 3 * MiB, WS_HB = 23 * MiB, WS_VF = 88 * MiB, WS_BIG = 152 * MiB;
constexpr size_t WS_R = WS_BIG, WS_K = WS_BIG + 64 * MiB, WS_V = WS_BIG + 128 * MiB, WS_W = WS_BIG + 192 * MiB, WS_A = WS_BIG + 256 * MiB, WS_LM = WS_BIG + 320 * MiB;
constexpr size_t WS_CTL = WS_LM + 32 * MiB;
constexpr size_t WS_END = WS_CTL + 16384;
constexpr size_t WB_WIN = 0, WB_WOUT = 5242880;
constexpr size_t WB_WR2 = 0, WB_WR3 = 14680064, WB_WG = 17039360, WB_WO = 17563648;
constexpr size_t WB_WGU = 0, WB_WD = 11534336;
constexpr int LDS_BYTES = 147456;

typedef __bf16 b16x2_t __attribute__((ext_vector_type(2)));
__device__ __forceinline__ unsigned cvt_pk_bf16(float lo, float hi) { const f32x2 v = {lo, hi}; return __builtin_bit_cast(unsigned, __builtin_convertvector(v, b16x2_t)); }
__device__ __forceinline__ float bf_lo(unsigned u) { return __uint_as_float(u << 16); }
__device__ __forceinline__ float bf_hi(unsigned u) { return __uint_as_float(u & 0xffff0000u); }
__device__ __forceinline__ float fexp2(float x) { return __builtin_amdgcn_exp2f(x); }
__device__ __forceinline__ float frcp(float x) { return __builtin_amdgcn_rcpf(x); }
__device__ __forceinline__ float fsigmoid(float x) { return frcp(1.f + fexp2(-x * LOG2E)); }
__device__ __forceinline__ float wave_sum(float v) {
#pragma unroll
    for (int o = 1; o < 64; o <<= 1) v += __shfl_xor(v, o);
    return v;
}
template <int CTRL> __device__ __forceinline__ float dpp_f(float v) {
    return __builtin_bit_cast(float, __builtin_amdgcn_update_dpp(0, __builtin_bit_cast(int, v), CTRL, 0xF, 0xF, true));
}
__device__ __forceinline__ float reduce16(float v) {
    v += dpp_f<0xB1>(v); v += dpp_f<0x4E>(v); v += dpp_f<0x141>(v); v += dpp_f<0x140>(v);
    return v;
}
__device__ __forceinline__ const float* ldp(const LAS unsigned* PL, int i) {
    unsigned lo = __builtin_amdgcn_readfirstlane(PL[2 * i]), hi = __builtin_amdgcn_readfirstlane(PL[2 * i + 1]);
    asm volatile("" : "+s"(lo), "+s"(hi));
    return (const float*)(((unsigned long long)hi << 32) | lo);
}
__device__ __forceinline__ int lane_id() { int l = (int)__builtin_amdgcn_mbcnt_hi(~0u, __builtin_amdgcn_mbcnt_lo(~0u, 0u)); asm volatile("" : "+v"(l)); return l; }
#define SC_MUL(d, a, b) asm("v_mul_f32 %0, %1, %2" : "=v"(d) : "v"(a), "v"(b))
#define SC_FMAC(d, a, b) asm("v_fmac_f32 %0, %1, %2" : "+v"(d) : "v"(a), "v"(b))
__device__ __forceinline__ f32x4 unpack4(const u32x2 w) { return (f32x4){bf_lo(w.x), bf_hi(w.x), bf_lo(w.y), bf_hi(w.y)}; }
typedef _Float16 f16x4 __attribute__((ext_vector_type(4)));
typedef _Float16 f16x8 __attribute__((ext_vector_type(8)));
__device__ __forceinline__ void unpack8h(const u32x4 w, f32x4& a, f32x4& b) { const f16x8 hv = __builtin_bit_cast(f16x8, w);
    a = __builtin_convertvector(__builtin_shufflevector(hv, hv, 0, 1, 2, 3), f32x4); b = __builtin_convertvector(__builtin_shufflevector(hv, hv, 4, 5, 6, 7), f32x4); }
__device__ __forceinline__ u32x4 pack8h(const f32x4 a, const f32x4 b) { const f16x4 x = __builtin_convertvector(a, f16x4), y = __builtin_convertvector(b, f16x4);
    return __builtin_bit_cast(u32x4, __builtin_shufflevector(x, y, 0, 1, 2, 3, 4, 5, 6, 7)); }
__device__ __forceinline__ f32x4 unpack4h(const u32x2 w) { return __builtin_convertvector(__builtin_bit_cast(f16x4, w), f32x4); }
#define LDS_WAIT() asm volatile("s_waitcnt lgkmcnt(0)" ::: "memory")

constexpr int BM = 256, BK = 64, HALF = 128, HTB = HALF * BK * 2, STAGE_BYTES = 8 * HTB, NXCD = 8, WGM = 8;
__host__ __device__ __forceinline__ int lds_byte(int r, int c) { const int st = (r >> 4) * 2 + (c >> 5), rr = r & 15, cc = c & 31, ob = rr * 64 + cc * 2; return st * 1024 + (ob ^ (((ob >> 9) & 1) << 5)); }
__host__ __device__ __forceinline__ void stage_rc(int b, int& R, int& C) { const int st = b / 1024, sb = b % 1024, swz = sb ^ (((sb >> 9) & 1) << 5); R = (st >> 1) * 16 + swz / 64; C = (st & 1) * 32 + (swz % 64) / 2; }
__host__ __device__ __forceinline__ int perm32(int rho) { const int n = rho >> 4, i = rho & 15; return 8 * (i >> 2) + 4 * n + (i & 3); }
struct Unit { int pm, pn; };
struct Gemm { const bf16_t* A; const bf16_t* Bt; int M, N, K, lda, ldb, apad, ksplit, off_lo, off_hi; int apn_shift; size_t apn_stride; };
struct StaticOrder {
    int nM, nN, nwg, G, c;
    __device__ void init(int M, int N, int G_, int c_) { nM = M / BM; nN = N / BM; nwg = nM * nN; G = G_; c = c_; }
    __device__ bool next(int i, Unit& u) const {
        const long L = (long)i * G + c; if (L >= nwg) return false;
        int wgid = (int)L; { const int q = nwg / NXCD, r = nwg % NXCD, xcd = wgid % NXCD, off = wgid / NXCD; wgid = (xcd < r ? xcd * (q + 1) : r * (q + 1) + (xcd - r) * q) + off; }
        const int nig = WGM * nN, gid = wgid / nig, fm = gid * WGM, gsz = (nM - fm) < WGM ? (nM - fm) : WGM;
        u.pm = fm + ((wgid % nig) % gsz); u.pn = (wgid % nig) / gsz; return true;
    }
};
typedef f32x4 Acc[2][2][4][2];

template <class Epi>
__device__ __forceinline__ void gemm_phase(LAS unsigned char* lds, const int wid, const Gemm g, const Epi& E) {
    const int lane = lane_id(), tid = wid * 64 + lane, wr = wid >> 2, wc = wid & 3, fr = lane & 15, fq = lane >> 4;
    const int nt = g.K / BK;
    StaticOrder S; S.init(g.M, g.N, (int)gridDim.x, (int)blockIdx.x);
    unsigned voffA[2], voffB[2];
#pragma unroll
    for (int i = 0; i < 2; ++i) { int R, C; stage_rc(tid * 16 + i * 8192, R, C); const int Rb = Epi::PERM ? ((R & ~31) + perm32(R & 31)) : R;
        voffA[i] = (unsigned)(R * g.lda + C) * 2u; voffB[i] = (unsigned)(Rb * g.ldb + C) * 2u; }
    const size_t kstep = (size_t)(BK * 2);
    const size_t hstepA = (size_t)HALF * g.lda * 2, hstepB = (size_t)HALF * g.ldb * 2;
    const unsigned ldsw = (unsigned)wid * 1024u;
    const int aoff = lds_byte(wr * 64 + fr, fq * 8), boff = lds_byte(wc * 32 + fr, fq * 8);
#define PG8_SA(b, h) (((b) * 2 + (h)) * HTB)
#define PG8_SB(b, h) ((4 + (b) * 2 + (h)) * HTB)
#define PG8_STAGE(bufoff, gbase, voff) do { const char* _gb = (const char*)(gbase); asm volatile("" : "+s"(_gb));     \
        _Pragma("unroll") for (int _i = 0; _i < 2; ++_i) \
        __builtin_amdgcn_global_load_lds((const unsigned*)(_gb + (voff)[_i]), (LAS unsigned*)(lds + (bufoff) + ldsw + _i * 8192), 16, 0, 0); } while (0)
#define PG8_LDA(dst, b, h) do { _Pragma("unroll") for (int m = 0; m < 4; ++m) _Pragma("unroll") for (int k = 0; k < 2; ++k) dst[m][k] = *(const LAS bf16x8*)(lds + PG8_SA(b, h) + aoff + m * 2048 + k * 1024); } while (0)
#define PG8_LDB(dst, b, h) do { _Pragma("unroll") for (int n = 0; n < 2; ++n) _Pragma("unroll") for (int k = 0; k < 2; ++k) dst[n][k] = *(const LAS bf16x8*)(lds + PG8_SB(b, h) + boff + n * 2048 + k * 1024); } while (0)
#define PG8_MMA(ai, bj, At, Bt) do { __builtin_amdgcn_s_setprio(1); _Pragma("unroll") for (int m = 0; m < 4; ++m) _Pragma("unroll") for (int n = 0; n < 2; ++n) _Pragma("unroll") for (int k = 0; k < 2; ++k) \
        acc[ai][bj][m][n] = __builtin_amdgcn_mfma_f32_16x16x32_bf16(Bt[n][k], At[m][k], acc[ai][bj][m][n], 0, 0, 0); __builtin_amdgcn_s_setprio(0); } while (0)
#define PG8_WAIT_V(n) asm volatile("s_waitcnt vmcnt(" #n ")" ::: "memory")
#define PG8_WAIT_L(n) asm volatile("s_waitcnt lgkmcnt(" #n ")" ::: "memory")
#define PG8_BAR __builtin_amdgcn_s_barrier()
#define PG8_SCHED __builtin_amdgcn_sched_barrier(0)
#define PG8_AP(base, kt) ((base) + (size_t)(kt) * kstep + (long)(((kt) < g.ksplit) ? g.off_lo : g.off_hi))
#define PG8_BP(base, kt) ((base) + (size_t)(kt) * kstep)
#define PG8_UA(u) ((const char*)g.A + ((size_t)(u).pm * BM + (size_t)((u).pm >> 4) * g.apad) * g.lda * 2 + (size_t)((u).pn >> g.apn_shift) * g.apn_stride)
#define PG8_UB(u) ((const char*)g.Bt + (size_t)(u).pn * BM * g.ldb * 2)
    Unit cur, nxt; int ui = 0;
    if (!S.next(0, cur)) return;
    Acc acc;
#pragma unroll
    for (int a = 0; a < 2; ++a)
#pragma unroll
        for (int b = 0; b < 2; ++b)
#pragma unroll
            for (int m = 0; m < 4; ++m)
#pragma unroll
                for (int n = 0; n < 2; ++n) acc[a][b][m][n] = (f32x4){0.f, 0.f, 0.f, 0.f};
    bf16x8 At[4][2], B0[2][2], B1[2][2];
    const char* cA = PG8_UA(cur); const char* cB = PG8_UB(cur);
    PG8_STAGE(PG8_SB(0, 0), PG8_BP(cB, 0), voffB); PG8_STAGE(PG8_SB(0, 1), PG8_BP(cB, 0) + hstepB, voffB); PG8_STAGE(PG8_SA(0, 0), PG8_AP(cA, 0), voffA); PG8_STAGE(PG8_SA(0, 1), PG8_AP(cA, 0) + hstepA, voffA);
    if (wr == 1) PG8_BAR;
    PG8_WAIT_V(2); PG8_BAR;
    PG8_STAGE(PG8_SB(1, 0), PG8_BP(cB, 1), voffB); PG8_STAGE(PG8_SA(1, 0), PG8_AP(cA, 1), voffA); PG8_STAGE(PG8_SB(1, 1), PG8_BP(cB, 1) + hstepB, voffB);
    PG8_WAIT_V(6); PG8_BAR;
    for (;;) {
        const bool has_next = S.next(ui + 1, nxt);
        const char* nA = has_next ? PG8_UA(nxt) : cA; const char* nB = has_next ? PG8_UB(nxt) : cB;
        for (int t = 0; t < nt; t += 2) {
            const bool last = (t == nt - 2);
            const char* a1 = PG8_AP(cA, t + 1);
            const char* a2 = last ? PG8_AP(nA, 0) : PG8_AP(cA, t + 2); const char* b2 = last ? PG8_BP(nB, 0) : PG8_BP(cB, t + 2);
            const char* a3 = last ? PG8_AP(nA, 1) : PG8_AP(cA, t + 3); const char* b3 = last ? PG8_BP(nB, 1) : PG8_BP(cB, t + 3);
            PG8_LDB(B0, 0, 0); PG8_LDB(B1, 0, 1); PG8_SCHED; PG8_LDA(At, 0, 0); PG8_STAGE(PG8_SA(1, 1), a1 + hstepA, voffA);
            PG8_WAIT_V(8); PG8_WAIT_L(0); PG8_BAR; PG8_MMA(0, 0, At, B0); PG8_MMA(0, 1, At, B1); PG8_BAR; PG8_SCHED;
            PG8_LDA(At, 0, 1); PG8_STAGE(PG8_SB(0, 0), b2, voffB); PG8_STAGE(PG8_SB(0, 1), b2 + hstepB, voffB); PG8_STAGE(PG8_SA(0, 0), a2, voffA);
            PG8_WAIT_V(8); PG8_WAIT_L(0); PG8_BAR; PG8_MMA(1, 0, At, B0); PG8_MMA(1, 1, At, B1); PG8_BAR; PG8_SCHED;
            PG8_LDB(B0, 1, 0); PG8_LDB(B1, 1, 1); PG8_SCHED; PG8_LDA(At, 1, 0); PG8_STAGE(PG8_SA(0, 1), a2 + hstepA, voffA);
            PG8_WAIT_V(8); PG8_WAIT_L(0); PG8_BAR; PG8_MMA(0, 0, At, B0); PG8_MMA(0, 1, At, B1); PG8_BAR; PG8_SCHED;
            PG8_LDA(At, 1, 1); PG8_STAGE(PG8_SB(1, 0), b3, voffB); PG8_STAGE(PG8_SB(1, 1), b3 + hstepB, voffB); PG8_STAGE(PG8_SA(1, 0), a3, voffA);
            PG8_WAIT_V(8); PG8_WAIT_L(0); PG8_BAR; PG8_MMA(1, 0, At, B0); PG8_MMA(1, 1, At, B1); PG8_BAR; PG8_SCHED;
        }
        if (wr == 0) PG8_BAR;
        { int le = lane; asm volatile("" : "+v"(le)); E(acc, cur, wr, wc, le & 15, le >> 4); }
        if (!has_next) break;
#pragma unroll
        for (int a = 0; a < 2; ++a)
#pragma unroll
            for (int b = 0; b < 2; ++b)
#pragma unroll
                for (int m = 0; m < 4; ++m)
#pragma unroll
                    for (int n = 0; n < 2; ++n) acc[a][b][m][n] = (f32x4){0.f, 0.f, 0.f, 0.f};
        cur = nxt; cA = nA; cB = nB; ++ui;
        if (wr == 1) PG8_BAR;
    }
    PG8_WAIT_V(0);
    PG8_BAR;
}
__device__ __forceinline__ u32x4 pack8(const f32x4 a, const f32x4 b) {
    u32x4 w; w.x = cvt_pk_bf16(a[0], a[1]); w.y = cvt_pk_bf16(a[2], a[3]); w.z = cvt_pk_bf16(b[0], b[1]); w.w = cvt_pk_bf16(b[2], b[3]); return w;
}
__device__ __forceinline__ void unpack8(const u32x4 w, f32x4& a, f32x4& b) {
    a[0] = bf_lo(w.x); a[1] = bf_hi(w.x); a[2] = bf_lo(w.y); a[3] = bf_hi(w.y); b[0] = bf_lo(w.z); b[1] = bf_hi(w.z); b[2] = bf_lo(w.w); b[3] = bf_hi(w.w);
}
struct EpiHybIn {
    static constexpr bool PERM = true;
    bf16_t* P; const float* qg; const float* kg;
    __device__ __forceinline__ void operator()(const Acc& acc, const Unit& u, int wr, int wc, int fr, int fq) const {
        const int kind = u.pn >> 1, half = u.pn & 1;
        const int row0 = u.pm * BM + wr * 64 + fr;
        if (kind < 2) {
            const float* gn = kind == 0 ? qg : kg; const float sc = kind == 0 ? QSCALE : 1.f;
            f32x4 gv[2][2];
#pragma unroll
            for (int bj = 0; bj < 2; ++bj)
#pragma unroll
                for (int n = 0; n < 2; ++n) gv[bj][n] = *(const GAS f32x4*)(gn + 32 * bj + 8 * fq + 4 * n);
            const int colb = kind * 512 + half * 256 + wc * 64 + 8 * fq;
#pragma unroll
            for (int ai = 0; ai < 2; ++ai)
#pragma unroll
                for (int m = 0; m < 4; ++m) {
                    float ss = 0.f;
#pragma unroll
                    for (int bj = 0; bj < 2; ++bj)
#pragma unroll
                        for (int n = 0; n < 2; ++n) { const f32x4 x = acc[ai][bj][m][n]; ss += (x[0] * x[0] + x[1] * x[1]) + (x[2] * x[2] + x[3] * x[3]); }
                    ss += __shfl_xor(ss, 16); ss += __shfl_xor(ss, 32);
                    const float rs = rsqrtf(ss * (1.f / 64.f) + 1e-6f) * sc;
                    bf16_t* rowp = P + (size_t)(row0 + ai * HALF + m * 16) * NPROJ + colb;
#pragma unroll
                    for (int bj = 0; bj < 2; ++bj) *(GAS u32x4*)(rowp + 32 * bj) = pack8(acc[ai][bj][m][0] * rs * gv[bj][0], acc[ai][bj][m][1] * rs * gv[bj][1]);
                }
        } else {
            const int colb = kind * 512 + half * 256 + wc * 32 + 8 * fq;
#pragma unroll
            for (int ai = 0; ai < 2; ++ai)
#pragma unroll
                for (int m = 0; m < 4; ++m) {
                    bf16_t* rowp = P + (size_t)(row0 + ai * HALF + m * 16) * NPROJ + colb;
#pragma unroll
                    for (int bj = 0; bj < 2; ++bj) {
                        f32x4 v0 = acc[ai][bj][m][0], v1 = acc[ai][bj][m][1];
                        if (kind == 3) {
#pragma unroll
                            for (int j = 0; j < 4; ++j) { v0[j] = fsigmoid(v0[j]); v1[j] = fsigmoid(v1[j]); }
                        }
                        *(GAS u32x4*)(rowp + 128 * bj) = pack8(v0, v1);
                    }
                }
        }
    }
};
template <bool BASE_F32, bool OUT_F32>
struct EpiRes {
    static constexpr bool PERM = true;
    const void* base; void* out;
    __device__ __forceinline__ void operator()(const Acc& acc, const Unit& u, int wr, int wc, int fr, int fq) const {
        const int row0 = u.pm * BM + wr * 64 + fr, col0 = u.pn * BM + wc * 32 + 8 * fq;
#pragma unroll
        for (int ai = 0; ai < 2; ++ai)
#pragma unroll
            for (int m = 0; m < 4; ++m) {
                const size_t off = (size_t)(row0 + ai * HALF + m * 16) * D + col0;
#pragma unroll
                for (int bj = 0; bj < 2; ++bj) {
                    const size_t p = off + bj * HALF;
                    f32x4 b0, b1;
                    if (BASE_F32) { b0 = *(const GAS f32x4*)((const float*)base + p); b1 = *(const GAS f32x4*)((const float*)base + p + 4); }
                    else unpack8h(*(const GAS u32x4*)((const bf16_t*)base + p), b0, b1);
                    b0 += acc[ai][bj][m][0]; b1 += acc[ai][bj][m][1];
                    if (OUT_F32) { *(GAS f32x4*)((float*)out + p) = b0; *(GAS f32x4*)((float*)out + p + 4) = b1; }
                    else *(GAS u32x4*)((bf16_t*)out + p) = pack8h(b0, b1);
                }
                asm volatile("" ::: "memory");
            }
    }
};
struct EpiSwiglu {
    static constexpr bool PERM = true;
    bf16_t* ACT;
    __device__ __forceinline__ void operator()(const Acc& acc, const Unit& u, int wr, int wc, int fr, int fq) const {
        const int row0 = u.pm * BM + wr * 64 + fr, col0 = u.pn * HALF + wc * 32 + 8 * fq;
#pragma unroll
        for (int ai = 0; ai < 2; ++ai)
#pragma unroll
            for (int m = 0; m < 4; ++m) {
                f32x4 o[2];
#pragma unroll
                for (int n = 0; n < 2; ++n)
#pragma unroll
                    for (int j = 0; j < 4; ++j) { const float gx = acc[ai][0][m][n][j]; o[n][j] = gx * fsigmoid(gx) * acc[ai][1][m][n][j]; }
                *(GAS u32x4*)(ACT + (size_t)(row0 + ai * HALF + m * 16) * F + col0) = pack8(o[0], o[1]);
            }
    }
};
struct EpiRwkvIn {
    static constexpr bool PERM = true;
    bf16_t* R; long koff, voff; bf16_t* LM; int pn_off;
    __device__ __forceinline__ void operator()(const Acc& acc, const Unit& u, int wr, int wc, int fr, int fq) const {
        const int lpn = u.pn + pn_off, t4 = lpn >> 2;
        const int row0 = u.pm * BM + wr * 64 + fr;
        if (t4 < 3) {
            bf16_t* dst = R + (t4 == 0 ? 0L : (t4 == 1 ? koff : voff));
            const int colb = (lpn & 3) * 256 + wc * 32 + 8 * fq;
#pragma unroll
            for (int ai = 0; ai < 2; ++ai)
#pragma unroll
                for (int m = 0; m < 4; ++m) {
                    bf16_t* rowp = dst + (size_t)(row0 + ai * HALF + m * 16) * D + colb;
#pragma unroll
                    for (int bj = 0; bj < 2; ++bj) *(GAS u32x4*)(rowp + 128 * bj) = pack8(acc[ai][bj][m][0], acc[ai][bj][m][1]);
                }
        } else {
            const int colb = (lpn - 12) * 256 + wc * 32 + 8 * fq;
#pragma unroll
            for (int ai = 0; ai < 2; ++ai)
#pragma unroll
                for (int m = 0; m < 4; ++m) {
                    bf16_t* rowp = LM + (size_t)(row0 + ai * HALF + m * 16) * 512 + colb;
#pragma unroll
                    for (int bj = 0; bj < 2; ++bj) {
                        const int c = colb + 128 * bj;
                        f32x4 v0 = acc[ai][bj][m][0], v1 = acc[ai][bj][m][1];
                        if (c < 64) {
#pragma unroll
                            for (int j = 0; j < 4; ++j) { v0[j] = 2.f * fsigmoid(2.f * v0[j]) - 1.f; v1[j] = 2.f * fsigmoid(2.f * v1[j]) - 1.f; }
                        } else if (c >= 128 && c < 288) {
#pragma unroll
                            for (int j = 0; j < 4; ++j) { v0[j] = fsigmoid(v0[j]); v1[j] = fsigmoid(v1[j]); }
                        }
                        *(GAS u32x4*)(rowp + 128 * bj) = pack8(v0, v1);
                    }
                }
        }
    }
};
struct EpiLoraUp {
    static constexpr bool PERM = true;
    bf16_t* W; const bf16_t* VF; const LAS unsigned* PL; int idx;
    __device__ __forceinline__ void operator()(const Acc& acc, const Unit& u, int wr, int wc, int fr, int fq) const {
        const int t4 = u.pn >> 2;
        const int row0 = u.pm * BM + wr * 64 + fr;
        const int colb = (u.pn & 3) * 256 + wc * 32 + 8 * fq;
        const float* bias = ldp(PL, t4 == 0 ? 17 : (t4 == 1 ? 20 : 31)) + (t4 < 2 ? idx * D : 0);
        bf16_t* dst = W + (t4 == 0 ? 0L : (t4 == 1 ? (long)(32u << 20) : -(long)(32u << 20)));
        const bf16_t* V = W - (long)(32u << 20);
        const float osc = t4 == 0 ? 0.60653065971f : 1.f;
#pragma unroll
        for (int bj = 0; bj < 2; ++bj) {
            const f32x4 b0 = *(const GAS f32x4*)(bias + colb + 128 * bj), b1 = *(const GAS f32x4*)(bias + colb + 128 * bj + 4);
#pragma unroll
            for (int ai = 0; ai < 2; ++ai)
#pragma unroll
                for (int m = 0; m < 4; ++m) {
                    const size_t off = (size_t)(row0 + ai * HALF + m * 16) * D + colb + 128 * bj;
                    f32x4 v0_ = acc[ai][bj][m][0] + b0, v1_ = acc[ai][bj][m][1] + b1;
#pragma unroll
                    for (int j = 0; j < 4; ++j) { v0_[j] = fsigmoid(v0_[j]) * osc; v1_[j] = fsigmoid(v1_[j]) * osc; }
                    if (t4 == 2) {
                        f32x4 x0, x1, f0, f1; unpack8(*(const GAS u32x4*)(V + off), x0, x1); unpack8(*(const GAS u32x4*)(VF + off), f0, f1);
                        v0_ = x0 + (f0 - x0) * v0_; v1_ = x1 + (f1 - x1) * v1_;
                    }
                    *(GAS u32x4*)(dst + off) = pack8(v0_, v1_);
                    asm volatile("" ::: "memory");
                }
        }
    }
};
struct EpiGPost {
    static constexpr bool PERM = true;
    const bf16_t *Y, *V; const float* BON; const float *ln_w, *ln_b; bf16_t* YG;
    __device__ __forceinline__ void operator()(const Acc& acc, const Unit& u, int wr, int wc, int fr, int fq) const {
        const int head = u.pn * 4 + wc;
        const int row0 = u.pm * BM + wr * 64 + fr;
        const int colb = head * 64 + 8 * fq;
#pragma unroll
        for (int ai = 0; ai < 2; ++ai)
#pragma unroll
            for (int m = 0; m < 4; ++m) {
                const int row = row0 + ai * HALF + m * 16;
                const size_t off = (size_t)row * D + colb;
                f32x4 y[2][2], v[2][2];
#pragma unroll
                for (int bj = 0; bj < 2; ++bj) { unpack8(*(const GAS u32x4*)(Y + off + 32 * bj), y[bj][0], y[bj][1]); unpack8(*(const GAS u32x4*)(V + off + 32 * bj), v[bj][0], v[bj][1]); }
                const float bs = BON[(size_t)row * 16 + head];
                float s = 0.f;
#pragma unroll
                for (int bj = 0; bj < 2; ++bj)
#pragma unroll
                    for (int n = 0; n < 2; ++n) s += (y[bj][n][0] + y[bj][n][1]) + (y[bj][n][2] + y[bj][n][3]);
                s += __shfl_xor(s, 16); s += __shfl_xor(s, 32);
                const float mean = s * (1.f / 64.f);
                float q = 0.f;
#pragma unroll
                for (int bj = 0; bj < 2; ++bj)
#pragma unroll
                    for (int n = 0; n < 2; ++n) { y[bj][n] = y[bj][n] - mean; q += (y[bj][n][0] * y[bj][n][0] + y[bj][n][1] * y[bj][n][1]) + (y[bj][n][2] * y[bj][n][2] + y[bj][n][3] * y[bj][n][3]); }
                q += __shfl_xor(q, 16); q += __shfl_xor(q, 32);
                const float rs = rsqrtf(q * (1.f / 64.f) + 64e-5f);
#pragma unroll
                for (int bj = 0; bj < 2; ++bj) {
                    f32x4 o[2];
#pragma unroll
                    for (int n = 0; n < 2; ++n) {
                        const f32x4 lw = *(const GAS f32x4*)(ln_w + colb + 32 * bj + 4 * n), lb = *(const GAS f32x4*)(ln_b + colb + 32 * bj + 4 * n);
                        o[n] = (y[bj][n] * rs * lw + lb + v[bj][n] * bs) * acc[ai][bj][m][n];
                    }
                    *(GAS u32x4*)(YG + off + 32 * bj) = pack8(o[0], o[1]);
                }
                asm volatile("" ::: "memory");
            }
    }
};
template <class Fn>
__device__ __forceinline__ void prep_mat(bf16_t* dst, int NR, int KC, int ldd, const Fn f, int& gw, int NGW, LAS float* scr, int lane) {
    const int nnb = NR / 32, ntile = nnb * (KC / 64);
    const int gw0 = gw; gw = (gw0 + NGW - ntile % NGW) % NGW;
    for (int it = gw0; it < ntile; it += NGW) {
        const int nb = it % nnb, kb = it / nnb, n0 = 32 * nb, k0 = 64 * kb;
#pragma unroll 4
        for (int i = 0; i < 32; ++i) { const int kk = 2 * i + (lane >> 5); scr[kk * 33 + (lane & 31)] = f(n0 + (lane & 31), k0 + kk); }
        LDS_WAIT(); asm volatile("" ::: "memory");
        const int c = lane & 7;
#pragma unroll
        for (int j = 0; j < 4; ++j) { const int n = (lane >> 3) + 8 * j; const LAS float* s = scr + (8 * c) * 33 + n;
            u32x4 o; o.x = cvt_pk_bf16(s[0 * 33], s[1 * 33]); o.y = cvt_pk_bf16(s[2 * 33], s[3 * 33]); o.z = cvt_pk_bf16(s[4 * 33], s[5 * 33]); o.w = cvt_pk_bf16(s[6 * 33], s[7 * 33]);
            *(GAS u32x4*)(dst + (size_t)(n0 + n) * ldd + k0 + 8 * c) = o; }
        LDS_WAIT(); asm volatile("" ::: "memory");
    }
}
__device__ __forceinline__ int headperm(int np) {
    const int t4 = np >> 8, p = np & 255, bj = p >> 7, wc = (p >> 5) & 3, e = p & 31;
    return t4 * 256 + wc * 64 + bj * 32 + e;
}
__device__ __forceinline__ void prep_hybrid(const float* w_in, const float* w_out, const float* pool_w, const float* pool_scale, bf16_t* WIN, bf16_t* WOUT, int gw, int NGW, LAS float* scr, int lane) {
    prep_mat(WIN, NPROJ, D, D, [=](int n, int k) -> float {
        const int src = n < 1024 ? headperm(n) : (n < 2048 ? n : n + 8);
        return w_in[(size_t)k * INC + src]; }, gw, NGW, scr, lane);
    prep_mat(WOUT, D, 512, D, [=](int n, int k) -> float { return w_out[(size_t)k * D + n]; }, gw, NGW, scr, lane);
    for (int it = gw; it < 1024; it += NGW) {
        const int g = it >> 8, c8 = (it >> 4) & 15, n = (it & 15) * 64 + lane;
        float a[8];
#pragma unroll
        for (int i = 0; i < 8; ++i) a[i] = 0.f;
        const float* pw = pool_w + ((size_t)g * 128 + c8 * 8) * 128;
#pragma unroll 4
        for (int d = 0; d < 128; ++d) {
            const float wv = w_out[(size_t)(512 + g * 128 + d) * D + n] * pool_scale[g * 128 + d];
#pragma unroll
            for (int i = 0; i < 8; ++i) a[i] += pw[i * 128 + d] * wv;
        }
        u32x4 o; o.x = cvt_pk_bf16(a[0], a[1]); o.y = cvt_pk_bf16(a[2], a[3]); o.z = cvt_pk_bf16(a[4], a[5]); o.w = cvt_pk_bf16(a[6], a[7]);
        *(GAS u32x4*)(WOUT + (size_t)n * D + 512 + g * 128 + c8 * 8) = o;
    }
}
__device__ __forceinline__ void prep_ffn(const float* wg, const float* wu, const float* wd, bf16_t* WGU, bf16_t* WD, int gw, int NGW, LAS float* scr, int lane) {
    prep_mat(WGU, 2 * F, D, D, [=](int n, int k) -> float {
        const int pn = n >> 8, p = n & 255, f = pn * 128 + (p & 127);
        const float* src = (p >> 7) ? wu : wg; return src[(size_t)k * F + f]; }, gw, NGW, scr, lane);
    prep_mat(WD, D, F, F, [=](int n, int k) -> float { return wd[(size_t)k * D + n]; }, gw, NGW, scr, lane);
}
__device__ __forceinline__ void prep_rwkv(const LAS unsigned* PL, int idx, bf16_t* WR2, bf16_t* WR3, bf16_t* WG, bf16_t* WO, int gw, int NGW, LAS float* scr, int lane) {
    const bool has_v = idx > 0;
    {
        const float* mu = ldp(PL, 13) + (size_t)idx * 6 * D;
        {
            const float* w_r = ldp(PL, 14) + (size_t)idx * D * D; const float* w_k = ldp(PL, 15) + (size_t)idx * D * D;
            prep_mat(WR2, 2048, 1024, 1024, [=](int n, int k) -> float { const float* W = (n >> 10) ? w_k : w_r; return W[(size_t)k * D + (n & 1023)]; }, gw, NGW, scr, lane);
        }
        {
            const float* w_v = ldp(PL, 16) + (size_t)idx * D * D;
            prep_mat(WR2 + (size_t)2048 * 1024, 1024, 2048, 2048, [=](int n, int kk) -> float {
                const int k = kk & 1023, hi = kk >> 10;
                const float m = mu[3 * D + k];
                return w_v[(size_t)k * D + n] * (hi ? m : 1.f - m); }, gw, NGW, scr, lane);
        }
        {
            const float* w1 = ldp(PL, 18) + (size_t)idx * D * 64; const float* a1 = ldp(PL, 21) + (size_t)idx * D * 64; const float* g1 = ldp(PL, 23) + (size_t)idx * D * 160; const float* v1 = ldp(PL, 32);
            prep_mat(WR2 + (size_t)2048 * 1024 + (size_t)1024 * 2048, 512, 2048, 2048, [=](int n, int kk) -> float {
                const int k = kk & 1023, hi = kk >> 10;
                float wv; int mi;
                if (n < 64) { wv = w1[(size_t)k * 64 + n]; mi = 1; }
                else if (n < 128) { wv = a1[(size_t)k * 64 + (n - 64)]; mi = 4; }
                else if (n < 288) { wv = g1[(size_t)k * 160 + (n - 128)]; mi = 5; }
                else if (n < 320 && has_v) { wv = v1[(size_t)k * 32 + (n - 288)]; mi = 3; }
                else return 0.f;
                const float m = mu[mi * D + k];
                return wv * (hi ? m : 1.f - m); }, gw, NGW, scr, lane);
        }
    }
    {
        const float* w2 = ldp(PL, 19) + (size_t)idx * 64 * D; const float* a2 = ldp(PL, 22) + (size_t)idx * 64 * D; const float* v2 = ldp(PL, 33);
        prep_mat(WR3, has_v ? 3072 : 2048, 384, 384, [=](int n, int k) -> float {
            const int t = n >> 10, c = n & 1023;
            if (t == 0) return k < 64 ? w2[(size_t)k * D + c] : 0.f;
            if (t == 1) return (k >= 64 && k < 128) ? a2[(size_t)(k - 64) * D + c] : 0.f;
            return (k >= 288 && k < 320) ? v2[(size_t)(k - 288) * D + c] : 0.f; }, gw, NGW, scr, lane);
    }
    {
        const float* g2 = ldp(PL, 24) + (size_t)idx * 160 * D;
        prep_mat(WG, D, 256, 256, [=](int n, int k) -> float { return k < 160 ? g2[(size_t)k * D + headperm(n)] : 0.f; }, gw, NGW, scr, lane);
    }
    {
        const float* w_o = ldp(PL, 30) + (size_t)idx * D * D;
        prep_mat(WO, D, D, D, [=](int n, int k) -> float { return w_o[(size_t)k * D + n]; }, gw, NGW, scr, lane);
    }
}

template <int MODE, bool XBF>
__device__ __forceinline__ void rmsnorm_rows(const void* x, const float* gain, bf16_t* H, int gw, int NGW, int lane, const LAS float* WF, const float* fbias, float* LF) {
    constexpr int RB = MODE == 1 ? 4 : 8;
    f32x4 g[2][2];
#pragma unroll
    for (int j = 0; j < 2; ++j) { g[j][0] = *(const GAS f32x4*)(gain + 512 * j + lane * 8); g[j][1] = *(const GAS f32x4*)(gain + 512 * j + lane * 8 + 4); }
    for (int row0 = gw * RB; row0 < T; row0 += NGW * RB) {
        f32x4 v[RB][2][2]; float s[RB];
#pragma unroll
        for (int r = 0; r < RB; ++r)
#pragma unroll
            for (int j = 0; j < 2; ++j) { const size_t xo = (size_t)(row0 + r) * D + 512 * j + lane * 8;
                if (XBF) unpack8h(*(const GAS u32x4*)((const bf16_t*)x + xo), v[r][j][0], v[r][j][1]);
                else { v[r][j][0] = *(const GAS f32x4*)((const float*)x + xo); v[r][j][1] = *(const GAS f32x4*)((const float*)x + xo + 4); } }
#pragma unroll
        for (int r = 0; r < RB; ++r) { s[r] = 0.f;
#pragma unroll
            for (int j = 0; j < 2; ++j)
#pragma unroll
                for (int e = 0; e < 2; ++e) s[r] += (v[r][j][e][0] * v[r][j][e][0] + v[r][j][e][1] * v[r][j][e][1]) + (v[r][j][e][2] * v[r][j][e][2] + v[r][j][e][3] * v[r][j][e][3]); }
#pragma unroll
        for (int o = 1; o < 64; o <<= 1)
#pragma unroll
            for (int r = 0; r < RB; ++r) s[r] += __shfl_xor(s[r], o);
#pragma unroll
        for (int r = 0; r < RB; ++r) {
            const int row = row0 + r;
            const float rstd = rsqrtf(s[r] * (1.f / D) + 1e-6f);
            const size_t hrow = MODE == 2 ? (size_t)row + (row >> 12) + 1 : (size_t)row;
#pragma unroll
            for (int j = 0; j < 2; ++j) { v[r][j][0] = v[r][j][0] * rstd * g[j][0]; v[r][j][1] = v[r][j][1] * rstd * g[j][1];
                *(GAS u32x4*)(H + hrow * D + 512 * j + lane * 8) = pack8(v[r][j][0], v[r][j][1]); }
        }
        if (MODE == 1) {
            float dt[RB][8];
#pragma unroll
            for (int r = 0; r < RB; ++r)
#pragma unroll
                for (int h = 0; h < 8; ++h) dt[r][h] = 0.f;
#pragma unroll
            for (int j = 0; j < 2; ++j)
#pragma unroll
                for (int e = 0; e < 2; ++e)
#pragma unroll
                    for (int c = 0; c < 4; ++c) {
                        const LAS float* wp = WF + (512 * j + lane * 8 + 4 * e + c) * 8;
                        const f32x4 w0 = *(const LAS f32x4*)wp, w1 = *(const LAS f32x4*)(wp + 4);
#pragma unroll
                        for (int r = 0; r < RB; ++r) {
                            const float hv = v[r][j][e][c];
                            dt[r][0] += hv * w0[0]; dt[r][1] += hv * w0[1]; dt[r][2] += hv * w0[2]; dt[r][3] += hv * w0[3];
                            dt[r][4] += hv * w1[0]; dt[r][5] += hv * w1[1]; dt[r][6] += hv * w1[2]; dt[r][7] += hv * w1[3];
                        }
                    }
            const bool hi32 = (lane & 32) != 0, hi16 = (lane & 16) != 0, hi8 = (lane & 8) != 0;
            const int hsel = (hi32 ? 4 : 0) + (hi16 ? 2 : 0) + (hi8 ? 1 : 0);
            const float fb = fbias[hsel];
#pragma unroll
            for (int r = 0; r < RB; ++r) {
                float d4[4], d2[2], d1;
#pragma unroll
                for (int k = 0; k < 4; ++k) { const float send = hi32 ? dt[r][k] : dt[r][k + 4], keep = hi32 ? dt[r][k + 4] : dt[r][k]; d4[k] = keep + __shfl_xor(send, 32); }
#pragma unroll
                for (int k = 0; k < 2; ++k) { const float send = hi16 ? d4[k] : d4[k + 2], keep = hi16 ? d4[k + 2] : d4[k]; d2[k] = keep + __shfl_xor(send, 16); }
                { const float send = hi8 ? d2[0] : d2[1], keep = hi8 ? d2[1] : d2[0]; d1 = keep + __shfl_xor(send, 8); }
                d1 += __shfl_xor(d1, 4); d1 += __shfl_xor(d1, 2); d1 += __shfl_xor(d1, 1);
                if ((lane & 7) == 0) {
                    const int row = row0 + r;
                    const float z = d1 + fb;
                    LF[((size_t)(row >> 12) * 8 + hsel) * S + (row & 4095)] = fminf(z, 0.f) - log1pf(__expf(-fabsf(z)));
                }
            }
        }
    }
}

__device__ __forceinline__ void rmsnorm_rows_rwkv(const bf16_t* x, const float* gain, const float* mu_r, const float* mu_k, bf16_t* H, bf16_t* XR, bf16_t* XK, int gw, int NGW, int lane) {
    constexpr int RB = 4;
    f32x4 g[2][2], mr[2][2], mk[2][2];
#pragma unroll
    for (int j = 0; j < 2; ++j)
#pragma unroll
        for (int e = 0; e < 2; ++e) { const int co = 512 * j + lane * 8 + 4 * e; g[j][e] = *(const GAS f32x4*)(gain + co); mr[j][e] = *(const GAS f32x4*)(mu_r + co); mk[j][e] = *(const GAS f32x4*)(mu_k + co); }
    for (int row0 = gw * RB; row0 < T; row0 += NGW * RB) {
        const bool first = (row0 & 4095) == 0;
        f32x4 v[RB + 1][2][2]; float s[RB + 1];
#pragma unroll
        for (int r = 0; r <= RB; ++r)
#pragma unroll
            for (int j = 0; j < 2; ++j) unpack8h(*(const GAS u32x4*)(x + (size_t)(row0 - 1 + r + (first && r == 0 ? 1 : 0)) * D + 512 * j + lane * 8), v[r][j][0], v[r][j][1]);
#pragma unroll
        for (int r = 0; r <= RB; ++r) { s[r] = 0.f;
#pragma unroll
            for (int j = 0; j < 2; ++j)
#pragma unroll
                for (int e = 0; e < 2; ++e) s[r] += (v[r][j][e][0] * v[r][j][e][0] + v[r][j][e][1] * v[r][j][e][1]) + (v[r][j][e][2] * v[r][j][e][2] + v[r][j][e][3] * v[r][j][e][3]); }
#pragma unroll
        for (int o = 1; o < 64; o <<= 1)
#pragma unroll
            for (int r = 0; r <= RB; ++r) s[r] += __shfl_xor(s[r], o);
#pragma unroll
        for (int r = 0; r <= RB; ++r) {
            const float rstd = (first && r == 0) ? 0.f : rsqrtf(s[r] * (1.f / D) + 1e-6f);
#pragma unroll
            for (int j = 0; j < 2; ++j)
#pragma unroll
                for (int e = 0; e < 2; ++e) v[r][j][e] = v[r][j][e] * rstd * g[j][e];
        }
#pragma unroll
        for (int r = 1; r <= RB; ++r) {
            const int row = row0 + r - 1;
            const size_t hrow = (size_t)row + (row >> 12) + 1;
#pragma unroll
            for (int j = 0; j < 2; ++j) {
                const size_t co = (size_t)512 * j + lane * 8;
                *(GAS u32x4*)(H + hrow * D + co) = pack8(v[r][j][0], v[r][j][1]);
                const f32x4 d0 = v[r - 1][j][0] - v[r][j][0], d1 = v[r - 1][j][1] - v[r][j][1];
                *(GAS u32x4*)(XR + (size_t)row * D + co) = pack8(v[r][j][0] + d0 * mr[j][0], v[r][j][1] + d1 * mr[j][1]);
                *(GAS u32x4*)(XK + (size_t)row * D + co) = pack8(v[r][j][0] + d0 * mk[j][0], v[r][j][1] + d1 * mk[j][1]);
            }
            if (first && r == 1) {
#pragma unroll
                for (int j = 0; j < 2; ++j) *(GAS u32x4*)(H + (hrow - 1) * D + 512 * j + lane * 8) = (u32x4){0u, 0u, 0u, 0u};
            }
        }
    }
}

constexpr int KPITCH = 144, VPITCH = 136;
__device__ __forceinline__ void attn_phase(LAS unsigned char* lds, const int wid, const bf16_t* P, const float* LF, bf16_t* CAT, const float* qgain, const float* kgain) {
    LAS float* CB = (LAS float*)lds;
    LAS unsigned char* KB = lds + 16384;
    LAS unsigned char* VB = KB + 2 * 64 * KPITCH;
    LAS float* red = (LAS float*)(VB + 2 * 64 * VPITCH);
    LAS unsigned* flg = (LAS unsigned*)(red + 16);
    float sbound;
    {
        float gq = fabsf(qgain[lane_id()]), gk = fabsf(kgain[lane_id()]);
#pragma unroll
        for (int o = 1; o < 64; o <<= 1) { gq = fmaxf(gq, __shfl_xor(gq, o)); gk = fmaxf(gk, __shfl_xor(gk, o)); }
        sbound = 64.f * QSCALE * gq * gk * 1.03f + 40.f;
    }
    const int lane = lane_id(), tid = wid * 64 + lane, r32 = lane & 31, hh = lane >> 5;
    const int ldkey = tid >> 3, ldd8 = (tid & 7) * 8;
    for (int w = blockIdx.x; w < 256; w += gridDim.x) {
        const int bh = w >> 2, jq = w & 3, b = bh >> 3, hd = bh & 7;
        __syncthreads();
        {
            const f32x4 l0 = *(const GAS f32x4*)(LF + (size_t)bh * S + tid * 8), l1 = *(const GAS f32x4*)(LF + (size_t)bh * S + tid * 8 + 4);
            float c[8]; c[0] = l0[0]; c[1] = c[0] + l0[1]; c[2] = c[1] + l0[2]; c[3] = c[2] + l0[3]; c[4] = c[3] + l1[0]; c[5] = c[4] + l1[1]; c[6] = c[5] + l1[2]; c[7] = c[6] + l1[3];
            float inc = c[7];
#pragma unroll
            for (int o = 1; o < 64; o <<= 1) { const float t = __shfl_up(inc, o); if (lane >= o) inc += t; }
            if (lane == 63) red[wid] = inc;
            __syncthreads();
            float base = inc - c[7];
            for (int i = 0; i < wid; ++i) base += red[i];
#pragma unroll
            for (int i = 0; i < 8; ++i) CB[tid * 8 + i] = -(base + c[i]) * LOG2E;
        }
        __syncthreads();
        const size_t tok0 = (size_t)b * S;
#pragma unroll 1
        for (int ui = 0; ui < 4; ++ui) {
            const int qb = ui == 0 ? jq : (ui == 1 ? 15 - jq : (ui == 2 ? 7 - jq : 8 + jq));
            const int q0 = qb * 256 + wid * 32, qrow = q0 + r32;
            bf16x8 qf[4];
#pragma unroll
            for (int ds = 0; ds < 4; ++ds) qf[ds] = *(const GAS bf16x8*)(P + (tok0 + qrow) * NPROJ + hd * 64 + 16 * ds + 8 * hh);
            f32x16 O[2];
#pragma unroll
            for (int i = 0; i < 16; ++i) { O[0][i] = 0.f; O[1][i] = 0.f; }
            float mrun = -1e30f, lsum = 0.f;
            unsigned done_w = 0u;
            const int ntile = 4 * qb + 4;
            u32x4 kreg, vreg;
            {
                const size_t gk = (tok0 + (size_t)(ntile - 1) * 64 + ldkey) * NPROJ + hd * 64 + ldd8;
                kreg = *(const GAS u32x4*)(P + gk + 512); vreg = *(const GAS u32x4*)(P + gk + 1024);
                *(LAS u32x4*)(KB + ldkey * KPITCH + ldd8 * 2) = kreg;
                LAS unsigned char* vb = VB + ldd8 * VPITCH + ldkey * 2;
                *(LAS bf16_t*)(vb + 0 * VPITCH) = (bf16_t)(vreg.x & 0xffff); *(LAS bf16_t*)(vb + 1 * VPITCH) = (bf16_t)(vreg.x >> 16);
                *(LAS bf16_t*)(vb + 2 * VPITCH) = (bf16_t)(vreg.y & 0xffff); *(LAS bf16_t*)(vb + 3 * VPITCH) = (bf16_t)(vreg.y >> 16);
                *(LAS bf16_t*)(vb + 4 * VPITCH) = (bf16_t)(vreg.z & 0xffff); *(LAS bf16_t*)(vb + 5 * VPITCH) = (bf16_t)(vreg.z >> 16);
                *(LAS bf16_t*)(vb + 6 * VPITCH) = (bf16_t)(vreg.w & 0xffff); *(LAS bf16_t*)(vb + 7 * VPITCH) = (bf16_t)(vreg.w >> 16);
            }
            __syncthreads();
#pragma unroll 1
            for (int it = 0; it < ntile; ++it) {
                const int kt = ntile - 1 - it, cb = it & 1;
                const bool more = it + 1 < ntile;
                if (more) {
                    const size_t gk = (tok0 + (size_t)(kt - 1) * 64 + ldkey) * NPROJ + hd * 64 + ldd8;
                    kreg = *(const GAS u32x4*)(P + gk + 512); vreg = *(const GAS u32x4*)(P + gk + 1024);
                }
                if (kt * 64 <= q0 + 31 && !done_w) {
                    const LAS unsigned char* kb_ = KB + cb * 64 * KPITCH;
                    const LAS unsigned char* vb_ = VB + cb * 64 * VPITCH;
                    f32x16 sacc[2];
                    __builtin_amdgcn_s_setprio(1);
#pragma unroll
                    for (int kb = 0; kb < 2; ++kb) {
#pragma unroll
                        for (int i = 0; i < 16; ++i) sacc[kb][i] = 0.f;
#pragma unroll
                        for (int ds = 0; ds < 4; ++ds) {
                            const bf16x8 a = *(const LAS bf16x8*)(kb_ + (kb * 32 + r32) * KPITCH + (16 * ds + 8 * hh) * 2);
                            sacc[kb] = __builtin_amdgcn_mfma_f32_32x32x16_bf16(a, qf[ds], sacc[kb], 0, 0, 0);
                        }
                    }
                    __builtin_amdgcn_s_setprio(0);
                    const bool diag = (kt * 64 + 63 > q0);
                    float mloc = -1e30f;
#pragma unroll
                    for (int kb = 0; kb < 2; ++kb)
#pragma unroll
                        for (int i4 = 0; i4 < 4; ++i4) {
                            const int kl = kb * 32 + 8 * i4 + 4 * hh;
                            const f32x4 bias = *(const LAS f32x4*)(CB + kt * 64 + kl);
#pragma unroll
                            for (int jj = 0; jj < 4; ++jj) {
                                float sv = sacc[kb][4 * i4 + jj] + bias[jj];
                                if (diag && (kt * 64 + kl + jj > qrow)) sv = -1e30f;
                                sacc[kb][4 * i4 + jj] = sv; mloc = fmaxf(mloc, sv);
                            }
                        }
                    mloc = fmaxf(mloc, __shfl_xor(mloc, 32));
                    const float mnew = fmaxf(mrun, mloc);
                    const float alpha = fexp2(mrun - mnew); mrun = mnew;
                    float ps = 0.f;
#pragma unroll
                    for (int kb = 0; kb < 2; ++kb)
#pragma unroll
                        for (int i = 0; i < 16; ++i) { const float p = fexp2(sacc[kb][i] - mnew); sacc[kb][i] = p; ps += p; }
                    lsum = lsum * alpha + ps;
#pragma unroll
                    for (int i = 0; i < 16; ++i) { O[0][i] *= alpha; O[1][i] *= alpha; }
#pragma unroll
                    for (int kb = 0; kb < 2; ++kb)
#pragma unroll
                        for (int s2 = 0; s2 < 2; ++s2) {
                            u32x4 pw; pw.x = cvt_pk_bf16(sacc[kb][8 * s2 + 0], sacc[kb][8 * s2 + 1]); pw.y = cvt_pk_bf16(sacc[kb][8 * s2 + 2], sacc[kb][8 * s2 + 3]);
                            pw.z = cvt_pk_bf16(sacc[kb][8 * s2 + 4], sacc[kb][8 * s2 + 5]); pw.w = cvt_pk_bf16(sacc[kb][8 * s2 + 6], sacc[kb][8 * s2 + 7]);
                            const bf16x8 pf = __builtin_bit_cast(bf16x8, pw);
#pragma unroll
                            for (int db = 0; db < 2; ++db) {
                                const LAS unsigned char* vp = vb_ + (db * 32 + r32) * VPITCH + (kb * 32 + 16 * s2 + 4 * hh) * 2;
                                const s16x4 lo = *(const LAS s16x4*)vp, hi = *(const LAS s16x4*)(vp + 16);
                                const bf16x8 av = __builtin_shufflevector(lo, hi, 0, 1, 2, 3, 4, 5, 6, 7);
                                O[db] = __builtin_amdgcn_mfma_f32_32x32x16_bf16(av, pf, O[db], 0, 0, 0);
                            }
                        }
                }
                if (kt * 64 <= q0 + 31 && !done_w && kt > 0) {
                    float mmin = mrun;
#pragma unroll
                    for (int o = 1; o < 32; o <<= 1) mmin = fminf(mmin, __shfl_xor(mmin, o));
                    done_w = (sbound + CB[kt * 64 - 1] < mmin) ? 1u : 0u;
                }
                if (lane == 0) flg[(it & 1) * 8 + wid] = done_w;
                if (more) {
                    const int nb = cb ^ 1;
                    *(LAS u32x4*)(KB + nb * 64 * KPITCH + ldkey * KPITCH + ldd8 * 2) = kreg;
                    LAS unsigned char* vb = VB + nb * 64 * VPITCH + ldd8 * VPITCH + ldkey * 2;
                    *(LAS bf16_t*)(vb + 0 * VPITCH) = (bf16_t)(vreg.x & 0xffff); *(LAS bf16_t*)(vb + 1 * VPITCH) = (bf16_t)(vreg.x >> 16);
                    *(LAS bf16_t*)(vb + 2 * VPITCH) = (bf16_t)(vreg.y & 0xffff); *(LAS bf16_t*)(vb + 3 * VPITCH) = (bf16_t)(vreg.y >> 16);
                    *(LAS bf16_t*)(vb + 4 * VPITCH) = (bf16_t)(vreg.z & 0xffff); *(LAS bf16_t*)(vb + 5 * VPITCH) = (bf16_t)(vreg.z >> 16);
                    *(LAS bf16_t*)(vb + 6 * VPITCH) = (bf16_t)(vreg.w & 0xffff); *(LAS bf16_t*)(vb + 7 * VPITCH) = (bf16_t)(vreg.w >> 16);
                }
                __syncthreads();
                {
                    const u32x4 f0 = *(const LAS u32x4*)(flg + (it & 1) * 8), f1 = *(const LAS u32x4*)(flg + (it & 1) * 8 + 4);
                    if ((f0.x & f0.y & f0.z & f0.w & f1.x & f1.y & f1.z & f1.w) != 0u) break;
                }
            }
            const float ltot = lsum + __shfl_xor(lsum, 32);
            const float inv = 1.f / ltot;
#pragma unroll
            for (int db = 0; db < 2; ++db)
#pragma unroll
                for (int i4 = 0; i4 < 4; ++i4) {
                    const int d0 = db * 32 + 8 * i4 + 4 * hh;
                    const u32x2 gt = *(const GAS u32x2*)(P + (tok0 + qrow) * NPROJ + 1536 + hd * 64 + d0);
                    u32x2 o; o.x = cvt_pk_bf16(O[db][4 * i4 + 0] * inv * bf_lo(gt.x), O[db][4 * i4 + 1] * inv * bf_hi(gt.x));
                    o.y = cvt_pk_bf16(O[db][4 * i4 + 2] * inv * bf_lo(gt.y), O[db][4 * i4 + 3] * inv * bf_hi(gt.y));
                    *(GAS u32x2*)(CAT + (tok0 + qrow) * D + hd * 64 + d0) = o;
                }
        }
    }
    for (int item = blockIdx.x * 512 + tid; item < T * 64; item += gridDim.x * 512) {
        const int t = item >> 6, c = (item & 63) * 8, g = c >> 7, wdw = 2 << g, pos = t & 4095;
        const int cnt = pos + 1 < wdw ? pos + 1 : wdw;
        f32x4 s0 = {0.f, 0.f, 0.f, 0.f}, s1 = s0, u0 = s0, u1 = s0;
        for (int j = 0; j < cnt; ++j) {
            f32x4 a, bq; unpack8(*(const GAS u32x4*)(P + (size_t)(t - j) * NPROJ + 2048 + c), a, bq);
            if (j == 0) { u0 = a; u1 = bq; }
            s0 += a; s1 += bq;
        }
        const float ic = 1.f / (float)cnt;
        *(GAS u32x4*)(CAT + (size_t)t * D + 512 + c) = pack8(s0 * ic - u0, s1 * ic - u1);
    }
}

constexpr int TC = 32;
__device__ __forceinline__ void scan_phase(LAS unsigned char* lds, const int wid, const bf16_t* R, const bf16_t* K, const bf16_t* V, const bf16_t* W, const bf16_t* A,
                                           const float* k_k, const float* k_a, const float* r_k, bf16_t* Y, float* BON) {
    const int tid = wid * 64 + lane_id(), row = tid >> 4, kq = tid & 15;
    for (int unit = blockIdx.x; unit < 256; unit += gridDim.x) {
        const int bh = unit >> 1, half = unit & 1, b = bh >> 4, h = bh & 15;
        const f32x4 kkp = *(const GAS f32x4*)(k_k + h * 64 + kq * 4), kap = *(const GAS f32x4*)(k_a + h * 64 + kq * 4), rkp = *(const GAS f32x4*)(r_k + h * 64 + kq * 4);
        float s0 = 0.f, s1 = 0.f, s2 = 0.f, s3 = 0.f;
        const size_t tokb = (size_t)b * S;
        const size_t gvec = (tokb + row) * D + h * 64 + kq * 4;
        const size_t gv = (tokb + row) * D + h * 64 + half * 32 + kq * 2;
        u32x2 rr, kr, wr_, ar; unsigned vr;
        rr = *(const GAS u32x2*)(R + gvec); kr = *(const GAS u32x2*)(K + gvec); wr_ = *(const GAS u32x2*)(W + gvec); ar = *(const GAS u32x2*)(A + gvec); vr = *(const GAS unsigned*)(V + gv);
        __syncthreads();
#pragma unroll 1
        for (int c = 0; c < S / TC; ++c) {
            LAS float* vec = (LAS float*)(lds + (c & 1) * 45056);
            LAS float* vvb = vec + 5 * TC * 64;
            LAS float* yb = (LAS float*)(lds + 90112 + (c & 1) * 4096);
            {
                const f32x4 kx = {bf_lo(kr.x), bf_hi(kr.x), bf_lo(kr.y), bf_hi(kr.y)};
                const f32x4 ax = {bf_lo(ar.x), bf_hi(ar.x), bf_lo(ar.y), bf_hi(ar.y)};
                const f32x4 wx = {bf_lo(wr_.x), bf_hi(wr_.x), bf_lo(wr_.y), bf_hi(wr_.y)};
                const f32x4 rx = {bf_lo(rr.x), bf_hi(rr.x), bf_lo(rr.y), bf_hi(rr.y)};
                f32x4 kk = kx * kkp;
                float ss = (kk[0] * kk[0] + kk[1] * kk[1]) + (kk[2] * kk[2] + kk[3] * kk[3]);
                ss = reduce16(ss);
                const float inv = 1.f / fmaxf(sqrtf(ss), 1e-12f);
                kk = kk * inv;
                const f32x4 km = kx * (1.f + (ax - 1.f) * kap);
                f32x4 dec; dec[0] = fexp2(-wx[0] * LOG2E); dec[1] = fexp2(-wx[1] * LOG2E); dec[2] = fexp2(-wx[2] * LOG2E); dec[3] = fexp2(-wx[3] * LOG2E);
                const f32x4 rkm = rx * km * rkp;
                float bs = (rkm[0] + rkm[1]) + (rkm[2] + rkm[3]);
                bs = reduce16(bs);
                if (half == 0 && kq == 0) BON[(tokb + (size_t)c * TC + row) * 16 + h] = bs;
                LAS float* vp = vec + row * 64 + kq * 4;
                *(LAS f32x4*)(vp + 0 * TC * 64) = -kk;
                *(LAS f32x4*)(vp + 1 * TC * 64) = kk * ax;
                *(LAS f32x4*)(vp + 2 * TC * 64) = dec;
                *(LAS f32x4*)(vp + 3 * TC * 64) = km;
                *(LAS f32x4*)(vp + 4 * TC * 64) = rx;
                vvb[row * 32 + kq * 2] = bf_lo(vr); vvb[row * 32 + kq * 2 + 1] = bf_hi(vr);
            }
            __syncthreads();
            if (c > 0) {
                const LAS float* pyb = (const LAS float*)(lds + 90112 + ((c - 1) & 1) * 4096);
                *(GAS unsigned*)(Y + gv + (size_t)(c - 1) * TC * D) = cvt_pk_bf16(pyb[row * 32 + kq * 2], pyb[row * 32 + kq * 2 + 1]);
            }
            if (c + 1 < S / TC) {
                const size_t o = (size_t)(c + 1) * TC * D;
                rr = *(const GAS u32x2*)(R + gvec + o); kr = *(const GAS u32x2*)(K + gvec + o); wr_ = *(const GAS u32x2*)(W + gvec + o); ar = *(const GAS u32x2*)(A + gvec + o); vr = *(const GAS unsigned*)(V + gv + o);
            }
#pragma unroll 1
            for (int tb = 0; tb < TC / 16; ++tb) {
                const LAS float* vp0 = vec + tb * 16 * 64 + kq * 4;
                const LAS float* vv0 = vvb + tb * 16 * 32 + row;
                f32x4 av = *(const LAS f32x4*)(vp0 + 0 * TC * 64), bv = *(const LAS f32x4*)(vp0 + 1 * TC * 64), dv = *(const LAS f32x4*)(vp0 + 2 * TC * 64),
                      kv = *(const LAS f32x4*)(vp0 + 3 * TC * 64), rv = *(const LAS f32x4*)(vp0 + 4 * TC * 64);
                float vv = vv0[0];
                float ykeep = 0.f;
#pragma unroll
                for (int j = 0; j < 16; ++j) {
                    f32x4 av_n = av, bv_n = bv, dv_n = dv, kv_n = kv, rv_n = rv; float vv_n = vv;
                    if (j < 15) {
                        const LAS float* vp = vp0 + (j + 1) * 64;
                        av_n = *(const LAS f32x4*)(vp + 0 * TC * 64); bv_n = *(const LAS f32x4*)(vp + 1 * TC * 64); dv_n = *(const LAS f32x4*)(vp + 2 * TC * 64);
                        kv_n = *(const LAS f32x4*)(vp + 3 * TC * 64); rv_n = *(const LAS f32x4*)(vp + 4 * TC * 64); vv_n = vv0[(j + 1) * 32];
                    }
                    float t, t2, u, u2;
                    SC_MUL(t, s0, av[0]); SC_FMAC(t, s1, av[1]); SC_MUL(t2, s2, av[2]); SC_FMAC(t2, s3, av[3]);
                    float sa = t + t2;
                    sa = reduce16(sa);
                    SC_MUL(s0, s0, dv[0]); SC_MUL(s1, s1, dv[1]); SC_MUL(s2, s2, dv[2]); SC_MUL(s3, s3, dv[3]);
                    SC_FMAC(s0, sa, bv[0]); SC_FMAC(s1, sa, bv[1]); SC_FMAC(s2, sa, bv[2]); SC_FMAC(s3, sa, bv[3]);
                    SC_FMAC(s0, vv, kv[0]); SC_FMAC(s1, vv, kv[1]); SC_FMAC(s2, vv, kv[2]); SC_FMAC(s3, vv, kv[3]);
                    SC_MUL(u, s0, rv[0]); SC_FMAC(u, s1, rv[1]); SC_MUL(u2, s2, rv[2]); SC_FMAC(u2, s3, rv[3]);
                    float y = u + u2;
                    y = reduce16(y);
                    ykeep = (kq == j) ? y : ykeep;
                    av = av_n; bv = bv_n; dv = dv_n; kv = kv_n; rv = rv_n; vv = vv_n;
                }
                yb[(tb * 16 + kq) * 32 + row] = ykeep;
            }
        }
        __syncthreads();
        {
            const LAS float* pyb = (const LAS float*)(lds + 90112 + ((S / TC - 1) & 1) * 4096);
            *(GAS unsigned*)(Y + gv + (size_t)(S / TC - 1) * TC * D) = cvt_pk_bf16(pyb[row * 32 + kq * 2], pyb[row * 32 + kq * 2 + 1]);
        }
        __syncthreads();
    }
}
#define SC2_BAR() do { asm volatile("s_waitcnt lgkmcnt(0)" ::: "memory"); __builtin_amdgcn_s_barrier(); asm volatile("" ::: "memory"); } while (0)
constexpr int CL = 16, NCH = S / CL;
constexpr int P_BK = 0, P_AR = 4608, P_BKT = 9216, P_VT = 14336, P_LAM = 15616, P_SIZE = 15872;
constexpr int Q_MKB = 0, Q_NBR = 512, Q_NKR = 1024, Q_TT = 1536, Q_SIZE = 2048;
constexpr int L_P = 0, L_Q = 3 * P_SIZE, L_MAB = L_Q + 2 * Q_SIZE, L_S16 = L_MAB + 1024, L_XU = L_S16 + 2 * 2304, L_CE = L_XU + 2 * 640, L_END2 = L_CE + 2 * 4096;
__device__ __forceinline__ f32x4 mfma16(const s16x4 a, const s16x4 b, const f32x4 c) { return __builtin_amdgcn_mfma_f32_16x16x16bf16_1k(a, b, c, 0, 0, 0); }
__device__ __forceinline__ f32x4 mfma32(const bf16x8 a, const bf16x8 b, const f32x4 c) { return __builtin_amdgcn_mfma_f32_16x16x32_bf16(a, b, c, 0, 0, 0); }
#define MF_SETTLE(v) do { } while (0)
__device__ __forceinline__ bf16_t f2bf(float x) { return (bf16_t)(cvt_pk_bf16(x, 0.f) & 0xffffu); }
__device__ __forceinline__ u32x2 pack4(const f32x4 v) { u32x2 o; o.x = cvt_pk_bf16(v[0], v[1]); o.y = cvt_pk_bf16(v[2], v[3]); return o; }

__device__ __forceinline__ void scan_phase2(LAS unsigned char* lds, const int wid, const bf16_t* R, const bf16_t* K, const bf16_t* V, const bf16_t* W, const bf16_t* A,
                                            const float* k_k, const float* k_a, const float* r_k, bf16_t* Y, float* BON) {
    const int lane = lane_id(), l15 = lane & 15, q = lane >> 4;
    for (int unit = blockIdx.x; unit < 256; unit += gridDim.x) {
        const int bh = unit >> 1, half = unit & 1, b = bh >> 4, h = bh & 15;
        const size_t tokb = (size_t)b * S;
        __syncthreads();
        if (wid == 7) {
            LAS float* CE0 = (LAS float*)(lds + L_CE);
            float c = 0.f;
#pragma unroll
            for (int i = 0; i < 16; ++i) { c += __uint_as_float((unsigned)W[(tokb + i) * D + h * 64 + lane] << 16); CE0[i * 64 + lane] = c; }
        }
        __syncthreads();
        if (wid == 2 || (wid >= 4 && wid < 7)) {
            const int idx = (wid == 2 ? 0 : wid - 3) * 64 + lane, s = idx >> 4, kq = idx & 15;
            const f32x4 kkp = *(const GAS f32x4*)(k_k + h * 64 + kq * 4), kap = *(const GAS f32x4*)(k_a + h * 64 + kq * 4), rkp = *(const GAS f32x4*)(r_k + h * 64 + kq * 4);
            const size_t gbase = tokb * D + h * 64;
            const unsigned lo_s = (unsigned)(s * D + kq * 4) * 2u;
            u32x2 rr, kr, ar, wr_;
#define SC2_LOAD(itn) do { const char* Rp = (const char*)(R + gbase + (size_t)(itn) * CL * D); const char* Kp = (const char*)(K + gbase + (size_t)(itn) * CL * D); \
                const char* Ap = (const char*)(A + gbase + (size_t)(itn) * CL * D); const char* Wp = (const char*)(W + gbase + (size_t)(itn) * CL * D); \
                asm volatile("" : "+s"(Rp), "+s"(Kp), "+s"(Ap), "+s"(Wp)); \
                rr = *(const GAS u32x2*)(Rp + lo_s); kr = *(const GAS u32x2*)(Kp + lo_s); ar = *(const GAS u32x2*)(Ap + lo_s); wr_ = *(const GAS u32x2*)(Wp + lo_s); } while (0)
            SC2_LOAD(0);
#pragma unroll 1
            for (int it = 0; it < NCH + 2; ++it) {
                if (it < NCH) for (int rp_ = 0; rp_ < 1 + ((MK_SC2P >> 1) & 1); ++rp_) {
                    LAS unsigned char* Pb = lds + L_P + (it % 3) * P_SIZE;
                    const f32x4 kx = unpack4(kr), ax = unpack4(ar), rx = unpack4(rr);
                    f32x4 kk = kx * kkp;
                    float ss = (kk[0] * kk[0] + kk[1] * kk[1]) + (kk[2] * kk[2] + kk[3] * kk[3]);
                    ss = reduce16(ss);
                    kk = kk * (1.f / fmaxf(sqrtf(ss), 1e-12f));
                    const f32x4 km = kx * (1.f + (ax - 1.f) * kap);
                    const f32x4 rkm = rx * km * rkp;
                    float bs = (rkm[0] + rkm[1]) + (rkm[2] + rkm[3]);
                    bs = reduce16(bs);
                    if (half == 0 && kq == 0) BON[(tokb + (size_t)it * CL + s) * 16 + h] = bs;
                    const f32x4 cum = *(const LAS f32x4*)(lds + L_CE + (it & 1) * 4096 + (s * 64 + kq * 4) * 4);
                    const f32x4 ews = unpack4(wr_);
                    f32x4 e1, e2, ed;
#pragma unroll
                    for (int i = 0; i < 4; ++i) { e1[i] = fexp2(cum[i] * LOG2E); e2[i] = frcp(e1[i]); ed[i] = fexp2(ews[i] * LOG2E); }
                    const f32x4 av = -kk, bv = kk * ax;
                    const f32x4 bbar = bv * e1, kbar = km * e1, abar = av * (e2 * ed), rbar = rx * e2;
                    *(LAS u32x2*)(Pb + P_BK + (s * 72 + kq * 4) * 2) = pack4(bbar);
                    *(LAS u32x2*)(Pb + P_BK + ((16 + s) * 72 + kq * 4) * 2) = pack4(kbar);
                    *(LAS u32x2*)(Pb + P_AR + (s * 72 + kq * 4) * 2) = pack4(abar);
                    *(LAS u32x2*)(Pb + P_AR + ((16 + s) * 72 + kq * 4) * 2) = pack4(rbar);
#pragma unroll
                    for (int i = 0; i < 4; ++i) {
                        *(LAS bf16_t*)(Pb + P_BKT + ((kq * 4 + i) * 40 + s) * 2) = f2bf(bbar[i]);
                        *(LAS bf16_t*)(Pb + P_BKT + ((kq * 4 + i) * 40 + 16 + s) * 2) = f2bf(kbar[i]);
                    }
                    if (s == 15) *(LAS f32x4*)(Pb + P_LAM + kq * 16) = e2;
                }
                if (it + 1 < NCH) SC2_LOAD(it + 1);
                SC2_BAR();
            }
        } else if (wid == 7) {
            const int j = lane >> 2, v8 = (lane & 3) * 8;
            const size_t gv = (tokb + j) * D + h * 64 + half * 32 + v8;
            u32x4 vr = *(const GAS u32x4*)(V + gv);
            const bf16_t* Wl = W + tokb * D + h * 64 + lane;
            bf16_t ewl[16];
#pragma unroll
            for (int i = 0; i < 16; ++i) ewl[i] = Wl[(size_t)(CL + i) * D];
#pragma unroll 1
            for (int it = 0; it < NCH + 2; ++it) {
                if (it < NCH) {
                    LAS unsigned char* vt = lds + L_P + (it % 3) * P_SIZE + P_VT + (v8 * 20 + j) * 2;
                    *(LAS bf16_t*)(vt + 0 * 40) = (bf16_t)(vr.x & 0xffff); *(LAS bf16_t*)(vt + 1 * 40) = (bf16_t)(vr.x >> 16);
                    *(LAS bf16_t*)(vt + 2 * 40) = (bf16_t)(vr.y & 0xffff); *(LAS bf16_t*)(vt + 3 * 40) = (bf16_t)(vr.y >> 16);
                    *(LAS bf16_t*)(vt + 4 * 40) = (bf16_t)(vr.z & 0xffff); *(LAS bf16_t*)(vt + 5 * 40) = (bf16_t)(vr.z >> 16);
                    *(LAS bf16_t*)(vt + 6 * 40) = (bf16_t)(vr.w & 0xffff); *(LAS bf16_t*)(vt + 7 * 40) = (bf16_t)(vr.w >> 16);
                }
                if (it + 1 < NCH) {
                    LAS float* CEn = (LAS float*)(lds + L_CE + ((it + 1) & 1) * 4096);
                    float c = 0.f;
#pragma unroll
                    for (int i = 0; i < 16; ++i) { c += __uint_as_float((unsigned)ewl[i] << 16); CEn[i * 64 + lane] = c; }
                    vr = *(const GAS u32x4*)(V + gv + (size_t)(it + 1) * CL * D);
                }
                if (it + 2 < NCH) {
#pragma unroll
                    for (int i = 0; i < 16; ++i) ewl[i] = Wl[(size_t)((it + 2) * CL + i) * D];
                }
                SC2_BAR();
            }
        } else if (wid == 3) {
            LAS float* MABS = (LAS float*)(lds + L_MAB);
#pragma unroll 1
            for (int it = 0; it < NCH + 2; ++it) {
                if (it >= 1 && it <= NCH) for (int rp_ = 0; rp_ < 1 + (MK_SC2P & 1); ++rp_) {
                    const LAS unsigned char* Pb = lds + L_P + ((it - 1) % 3) * P_SIZE;
                    LAS unsigned char* Qb = lds + L_Q + ((it - 1) & 1) * Q_SIZE;
                    f32x4 mn[2][2];
#pragma unroll
                    for (int jt = 0; jt < 2; ++jt)
#pragma unroll
                        for (int st = 0; st < 2; ++st) {
                            mn[jt][st] = (f32x4){0.f, 0.f, 0.f, 0.f};
#pragma unroll
                            for (int ks = 0; ks < 2; ++ks) {
                                const bf16x8 af = *(const LAS bf16x8*)(Pb + P_BK + ((16 * jt + l15) * 72 + 32 * ks + 8 * q) * 2);
                                const bf16x8 bf = *(const LAS bf16x8*)(Pb + P_AR + ((16 * st + l15) * 72 + 32 * ks + 8 * q) * 2);
                                mn[jt][st] = mfma32(af, bf, mn[jt][st]);
                            }
                        }
#pragma unroll
                    for (int i = 0; i < 4; ++i) {
                        const int j = 4 * q + i;
                        if (!(j < l15)) { mn[0][0][i] = 0.f; mn[1][0][i] = 0.f; }
                        if (!(j <= l15)) { mn[0][1][i] = 0.f; mn[1][1][i] = 0.f; }
                    }
                    *(LAS u32x2*)(Qb + Q_MKB + (l15 * 16 + 4 * q) * 2) = pack4(mn[1][0]);
                    *(LAS u32x2*)(Qb + Q_NBR + (l15 * 16 + 4 * q) * 2) = pack4(mn[0][1]);
                    *(LAS u32x2*)(Qb + Q_NKR + (l15 * 16 + 4 * q) * 2) = pack4(mn[1][1]);
#pragma unroll
                    for (int r = 0; r < 4; ++r) MABS[(4 * q + r) * 16 + l15] = mn[0][0][r];
                    LDS_WAIT(); asm volatile("" ::: "memory");
                    f32x4 MR[15][4];
#pragma unroll
                    for (int i = 0; i < 15; ++i)
#pragma unroll
                        for (int g = 0; g < 4; ++g) if (4 * g + 3 > i) MR[i][g] = *(const LAS f32x4*)(MABS + i * 16 + 4 * g);
                    LDS_WAIT(); asm volatile("" ::: "memory");
                    float Tr[16], Ps[16];
#pragma unroll
                    for (int s2 = 0; s2 < 16; ++s2) Ps[s2] = 0.f;
#pragma unroll
                    for (int i = 0; i < 16; ++i) {
                        const float Ti = ((l15 == i) ? 1.f : 0.f) + Ps[i];
                        Tr[i] = Ti;
                        if (i < 15) {
#pragma unroll
                            for (int s2 = 0; s2 < 16; ++s2) if (s2 > i) Ps[s2] += Ti * MR[i][s2 >> 2][s2 & 3];
                        }
                    }
#pragma unroll
                    for (int s = 0; s < 16; ++s) *(LAS bf16_t*)(Qb + Q_TT + (s * 16 + l15) * 2) = f2bf(Tr[s]);
                }
                SC2_BAR();
            }
        } else {
            LAS unsigned char* S16 = lds + L_S16 + wid * 2304;
            LAS unsigned char* XU = lds + L_XU + wid * 640;
            f32x4 St[4];
#pragma unroll
            for (int kt = 0; kt < 4; ++kt) St[kt] = (f32x4){0.f, 0.f, 0.f, 0.f};
            for (int e = lane; e < 16 * 72 / 2; e += 64) ((LAS unsigned*)S16)[e] = 0u;
            LDS_WAIT();
#pragma unroll 1
            for (int it = 0; it < NCH + 2; ++it) {
                if (it >= 2) {
                    const int c = it - 2;
                    const LAS unsigned char* Pb = lds + L_P + (c % 3) * P_SIZE;
                    const LAS unsigned char* Qb = lds + L_Q + (c & 1) * Q_SIZE;
                    bf16x8 sa[2];
#pragma unroll
                    for (int ks = 0; ks < 2; ++ks) sa[ks] = *(const LAS bf16x8*)(S16 + (l15 * 72 + 32 * ks + 8 * q) * 2);
                    const s16x4 va = *(const LAS s16x4*)(Pb + P_VT + ((16 * wid + l15) * 20 + 4 * q) * 2);
                    f32x4 X = {0.f, 0.f, 0.f, 0.f}, Yc = X;
#pragma unroll
                    for (int ks = 0; ks < 2; ++ks) {
                        X = mfma32(sa[ks], *(const LAS bf16x8*)(Pb + P_AR + (l15 * 72 + 32 * ks + 8 * q) * 2), X);
                        Yc = mfma32(sa[ks], *(const LAS bf16x8*)(Pb + P_AR + ((16 + l15) * 72 + 32 * ks + 8 * q) * 2), Yc);
                    }
                    X = mfma16(va, *(const LAS s16x4*)(Qb + Q_MKB + (l15 * 16 + 4 * q) * 2), X);
                    Yc = mfma16(va, *(const LAS s16x4*)(Qb + Q_NKR + (l15 * 16 + 4 * q) * 2), Yc);
                    MF_SETTLE(X);
#pragma unroll
                    for (int i = 0; i < 4; ++i) *(LAS bf16_t*)(XU + ((4 * q + i) * 20 + l15) * 2) = f2bf(X[i]);
                    LDS_WAIT(); asm volatile("" ::: "memory");
                    const s16x4 xa = *(const LAS s16x4*)(XU + (l15 * 20 + 4 * q) * 2);
                    f32x4 U = mfma16(xa, *(const LAS s16x4*)(Qb + Q_TT + (l15 * 16 + 4 * q) * 2), (f32x4){0.f, 0.f, 0.f, 0.f});
                    LDS_WAIT(); asm volatile("" ::: "memory");
                    MF_SETTLE(U);
#pragma unroll
                    for (int i = 0; i < 4; ++i) *(LAS bf16_t*)(XU + ((4 * q + i) * 20 + l15) * 2) = f2bf(U[i]);
                    LDS_WAIT(); asm volatile("" ::: "memory");
                    const s16x4 ua = *(const LAS s16x4*)(XU + (l15 * 20 + 4 * q) * 2);
                    Yc = mfma16(ua, *(const LAS s16x4*)(Qb + Q_NBR + (l15 * 16 + 4 * q) * 2), Yc);
                    MF_SETTLE(Yc);
                    *(GAS u32x2*)(Y + (tokb + (size_t)c * CL + l15) * D + h * 64 + half * 32 + 16 * wid + 4 * q) = pack4(Yc);
#pragma unroll
                    for (int kt = 0; kt < 4; ++kt) {
                        const float lam = *(const LAS float*)(Pb + P_LAM + (16 * kt + l15) * 4);
                        St[kt] = mfma16(ua, *(const LAS s16x4*)(Pb + P_BKT + ((16 * kt + l15) * 40 + 4 * q) * 2), St[kt]);
                        St[kt] = mfma16(va, *(const LAS s16x4*)(Pb + P_BKT + ((16 * kt + l15) * 40 + 16 + 4 * q) * 2), St[kt]);
                        St[kt] = St[kt] * lam;
                    }
#pragma unroll
                    for (int kt = 0; kt < 4; ++kt)
#pragma unroll
                        for (int i = 0; i < 4; ++i) *(LAS bf16_t*)(S16 + ((4 * q + i) * 72 + 16 * kt + l15) * 2) = f2bf(St[kt][i]);
                    LDS_WAIT(); asm volatile("" ::: "memory");
                }
                SC2_BAR();
            }
        }
    }
}
#if MK_SCAN2
#define SCAN_FN scan_phase2
#else
#define SCAN_FN scan_phase
#endif
struct Params { const float* in[34]; float* out; unsigned char* ws; int lo, hi, coop, pad; };
constexpr int NPHASE = 32;

#define XB_TMO      128
#define XB_XCNT(j)  (256  + 64 * (j))
#define XB_XSUB(j)  (1280 + 64 * (j))
#define XB_XGEN(j)  (2304 + 64 * (j))
#define XB_TOP      3328
#define XB_TOPGEN   3392
#define XCD_BAR_WORDS 3456
#define XB_SPIN_CAP (1u << 20)
__device__ __forceinline__ unsigned xb_ld(unsigned* p)              { return __hip_atomic_load(p, __ATOMIC_RELAXED, __HIP_MEMORY_SCOPE_AGENT); }
__device__ __forceinline__ unsigned xb_add(unsigned* p, unsigned v) { return __hip_atomic_fetch_add(p, v, __ATOMIC_RELAXED, __HIP_MEMORY_SCOPE_AGENT); }
__device__ __forceinline__ unsigned xb_xcc_id() { return (unsigned)__builtin_amdgcn_s_getreg((3 << 11) | 20) & 0xFu; }
#define XB_SPIN(cond, bar) do { unsigned _sp = 0; while (cond) { \
    if ((++_sp & 255u) == 0u) { if (xb_ld(&(bar)[XB_TMO])) break; if (_sp > XB_SPIN_CAP) { atomicAdd(&(bar)[XB_TMO], 1u); break; } } } } while (0)
__device__ __forceinline__ void xcd_barrier_complete(unsigned* bar, unsigned x, unsigned& nloc, unsigned& nx) {
    const unsigned G = gridDim.x * gridDim.y * gridDim.z;
    unsigned sum, cnt, mine, sp = 0u;
    for (;;) {
        sum = 0u; cnt = 0u; mine = 0u;
#pragma unroll
        for (unsigned j = 0; j < 16; ++j) { const unsigned c = xb_ld(&bar[XB_XCNT(j)]); sum += c; cnt += (c > 0u) ? 1u : 0u; mine = (j == x) ? c : mine; }
        if (sum == G) break;
        __builtin_amdgcn_s_sleep(1);
        if ((++sp & 255u) == 0u) { if (xb_ld(&bar[XB_TMO])) break; if (sp > XB_SPIN_CAP) { atomicAdd(&bar[XB_TMO], 1u); break; } }
    }
    nloc = mine > 0u ? mine : 1u; nx = cnt > 0u ? cnt : 1u;
}
__device__ __forceinline__ void grid_barrier(unsigned* bar, volatile LAS unsigned* st, int wid) {
    asm volatile("s_waitcnt vmcnt(0)" ::: "memory");
    __syncthreads();
    if (wid == 0) {
        if (lane_id() == 0) {
            const unsigned x = xb_xcc_id();
            __builtin_amdgcn_s_waitcnt(0);
            unsigned nloc = st[0], nx = st[1];
            if (nloc == 0u) { xcd_barrier_complete(bar, x, nloc, nx); st[0] = nloc; st[1] = nx; }
            const unsigned old = xb_add(&bar[XB_XSUB(x)], 1u);
            const unsigned gen = old / nloc;
            if (old + 1u == (gen + 1u) * nloc) {
                __builtin_amdgcn_fence(__ATOMIC_RELEASE, "agent");
                asm volatile("s_waitcnt vmcnt(0)" ::: "memory");
                const unsigned og = xb_add(&bar[XB_TOP], 1u);
                const unsigned tg = og / nx;
                if (og + 1u == (tg + 1u) * nx) xb_add(&bar[XB_TOPGEN], 1u);
                else XB_SPIN(xb_ld(&bar[XB_TOPGEN]) == tg, bar);
                __builtin_amdgcn_fence(__ATOMIC_ACQUIRE, "agent");
                xb_add(&bar[XB_XGEN(x)], 1u);
                asm volatile("s_waitcnt vmcnt(0)" ::: "memory");
            } else {
                XB_SPIN(xb_ld(&bar[XB_XGEN(x)]) == gen, bar);
                __builtin_amdgcn_fence(__ATOMIC_ACQUIRE, "agent");
                asm volatile("s_waitcnt vmcnt(0)" ::: "memory");
            }
        }
    }
    __syncthreads();
}

__global__ void __launch_bounds__(512, 2) mk_fwd(Params p) {
    extern __shared__ __attribute__((aligned(16))) unsigned char lds_raw[];
    LAS unsigned char* lds = (LAS unsigned char*)lds_raw;
    if (p.coop) cg::this_grid().sync();
    LAS unsigned* PL = (LAS unsigned*)(lds + 131072);
    int wid_s = __builtin_amdgcn_readfirstlane((int)threadIdx.x >> 6);
    if (threadIdx.x < 36) { const unsigned long long v = threadIdx.x < 34 ? (unsigned long long)p.in[threadIdx.x] : (threadIdx.x == 34 ? (unsigned long long)p.out : (unsigned long long)p.ws);
        PL[2 * threadIdx.x] = (unsigned)v; PL[2 * threadIdx.x + 1] = (unsigned)(v >> 32); }
    volatile LAS unsigned* BST = (volatile LAS unsigned*)(lds + 131072 + 512);
    if (threadIdx.x == 64) { BST[0] = 0u; BST[1] = 0u; }
    if (threadIdx.x == 0 && p.hi - p.lo > 1) (void)xb_add((unsigned*)(p.ws + WS_CTL) + XB_XCNT(xb_xcc_id()), 1u);
    __syncthreads();
#define PIN(i) ldp(PL, (i))
    const int ph_lo = p.lo, ph_hi = p.hi;
#define WSP ((unsigned char*)PIN(35))
#define OUT ((float*)PIN(34))
#define LF ((float*)(WSP + WS_LF))
#define BON ((float*)(WSP + WS_BON))
#define HB ((bf16_t*)(WSP + WS_HB))
#define VF ((bf16_t*)OUT)
#define XB ((bf16_t*)(WSP + WS_VF))
#define PROJ ((bf16_t*)(WSP + WS_BIG))
#define ACT ((bf16_t*)(WSP + WS_BIG))
#define RB ((bf16_t*)(WSP + WS_R))
#define KB_ ((bf16_t*)(WSP + WS_K))
#define VB_ ((bf16_t*)(WSP + WS_V))
#define WBUF ((bf16_t*)(WSP + WS_W))
#define AB ((bf16_t*)(WSP + WS_A))
#define LM ((bf16_t*)(WSP + WS_LM))
#define WB (WSP + WS_WB)
    constexpr int BIGK = 1 << 30;
#define PH_BEGIN(X, KIND) if (ph_lo <= (X) && (X) < ph_hi) { _Pragma("unroll 1") for (int rep_ = 0; rep_ < 1 + ((MK_DOUBLE >> (KIND)) & 1); ++rep_) { const int wid = wid_s, lane = lane_id(), tid = wid * 64 + lane; const int gw = (int)blockIdx.x * 8 + wid, NGW = (int)gridDim.x * 8; LAS float* scr = (LAS float*)(lds + wid * 8448); (void)tid; (void)gw; (void)NGW; (void)scr; (void)lane;
#define PH_END(X) } if ((X) + 1 < ph_hi) { grid_barrier((unsigned*)(WSP + WS_CTL), (volatile LAS unsigned*)(lds + 131072 + 512), wid_s); if (MK_BAR2) grid_barrier((unsigned*)(WSP + WS_CTL), (volatile LAS unsigned*)(lds + 131072 + 512), wid_s); } asm volatile("" : "+s"(wid_s)); }
#define FFN_PHASES(layer, P0) \
    PH_BEGIN(P0, 0) \
        prep_ffn(PIN(3) + (size_t)(layer) * D * F, PIN(4) + (size_t)(layer) * D * F, PIN(5) + (size_t)(layer) * F * D, (bf16_t*)(WB + WB_WGU), (bf16_t*)(WB + WB_WD), gw, NGW, scr, lane); \
        rmsnorm_rows<0, true>(XB, PIN(2) + (layer) * D, HB, gw, NGW, lane, nullptr, nullptr, nullptr); \
    PH_END(P0) \
    PH_BEGIN(P0 + 1, 3) \
        const Gemm g{HB, (const bf16_t*)(WB + WB_WGU), T, 2 * F, D, D, D, 0, BIGK, 0, 0, 31, 0}; \
        gemm_phase(lds, wid, g, EpiSwiglu{ACT}); \
    PH_END(P0 + 1) \
    PH_BEGIN(P0 + 2, 5) \
        const Gemm g{ACT, (const bf16_t*)(WB + WB_WD), T, D, F, F, F, 0, BIGK, 0, 0, 31, 0}; \
        gemm_phase(lds, wid, g, EpiRes<false, (layer) == 3>{XB, (layer) == 3 ? (void*)OUT : (void*)XB}); \
    PH_END(P0 + 2)
#define HYBRID_PHASES(layer, idx, P0) \
    PH_BEGIN(P0, 0) \
        const float* w_in = PIN(6) + (size_t)(idx) * D * INC; \
        LAS float* WF = (LAS float*)(lds + 98304); \
        for (int k = tid; k < D; k += 512) { const f32x4 a = *(const f32x4*)(w_in + (size_t)k * INC + 2048), b = *(const f32x4*)(w_in + (size_t)k * INC + 2052); \
            *(LAS f32x4*)(WF + k * 8) = a; *(LAS f32x4*)(WF + k * 8 + 4) = b; } \
        __syncthreads(); \
        prep_hybrid(w_in, PIN(12) + (size_t)(idx) * D * D, PIN(10) + (size_t)(idx) * 4 * 128 * 128, PIN(11) + (idx) * 512, (bf16_t*)(WB + WB_WIN), (bf16_t*)(WB + WB_WOUT), gw, NGW, scr, lane); \
        rmsnorm_rows<1, (layer) != 0>((layer) == 0 ? (const void*)PIN(0) : (const void*)XB, PIN(1) + (layer) * D, HB, gw, NGW, lane, WF, PIN(7) + (idx) * 8, LF); \
    PH_END(P0) \
    PH_BEGIN(P0 + 1, 1) \
        const Gemm g{HB, (const bf16_t*)(WB + WB_WIN), T, NPROJ, D, D, D, 0, BIGK, 0, 0, 31, 0}; \
        gemm_phase(lds, wid, g, EpiHybIn{PROJ, PIN(8) + (idx) * 64, PIN(9) + (idx) * 64}); \
    PH_END(P0 + 1) \
    PH_BEGIN(P0 + 2, 2) \
        attn_phase(lds, wid, PROJ, LF, HB, PIN(8) + (idx) * 64, PIN(9) + (idx) * 64); \
    PH_END(P0 + 2) \
    PH_BEGIN(P0 + 3, 8) \
        const Gemm g{HB, (const bf16_t*)(WB + WB_WOUT), T, D, D, D, D, 0, BIGK, 0, 0, 31, 0}; \
        gemm_phase(lds, wid, g, EpiRes<(layer) == 0, false>{(layer) == 0 ? (const void*)PIN(0) : (const void*)XB, XB}); \
    PH_END(P0 + 3) \
    FFN_PHASES(layer, P0 + 4)
#define RWKV_PHASES(layer, idx, P0) \
    PH_BEGIN(P0, 0) \
        prep_rwkv(PL, idx, (bf16_t*)(WB + WB_WR2), (bf16_t*)(WB + WB_WR3), (bf16_t*)(WB + WB_WG), (bf16_t*)(WB + WB_WO), gw, NGW, scr, lane); \
        rmsnorm_rows_rwkv(XB, PIN(1) + (layer) * D, PIN(13) + (size_t)(idx) * 6 * D, PIN(13) + (size_t)(idx) * 6 * D + 2 * D, HB, WBUF, AB, gw, NGW, lane); \
    PH_END(P0) \
    PH_BEGIN(P0 + 1, 4) \
        {     \
            const Gemm g{WBUF, (const bf16_t*)(WB + WB_WR2), T, 2048, D, D, D, 0, BIGK, 0, 0, 2, (size_t)(WS_A - WS_W)}; \
            gemm_phase(lds, wid, g, EpiRwkvIn{RB, (long)((WS_K - WS_R) / 2), 0L, LM, 0}); \
        } \
        {     \
            const Gemm g{HB, (const bf16_t*)(WB + WB_WR2 + (size_t)2048 * 1024 * 2), T, 1536, 2048, D, 2048, 1, 16, 2048, -2048, 31, 0}; \
            gemm_phase(lds, wid, g, EpiRwkvIn{RB, (long)((WS_K - WS_R) / 2), (idx) == 0 ? (long)(VF - RB) : (long)((WS_V - WS_R) / 2), LM, 8}); \
        } \
    PH_END(P0 + 1) \
    PH_BEGIN(P0 + 2, 15) \
        const Gemm g{LM, (const bf16_t*)(WB + WB_WR3), T, (idx) > 0 ? 3072 : 2048, 384, 512, 384, 0, BIGK, 0, 0, 31, 0}; \
        gemm_phase(lds, wid, g, EpiLoraUp{WBUF, VF, PL, idx}); \
    PH_END(P0 + 2) \
    PH_BEGIN(P0 + 3, 6) \
        SCAN_FN(lds, wid, RB, KB_, ((idx) == 0 ? VF : VB_), WBUF, AB, PIN(25) + (idx) * D, PIN(26) + (idx) * D, PIN(27) + (idx) * D, HB, BON); \
    PH_END(P0 + 3) \
    PH_BEGIN(P0 + 4, 7) \
        const Gemm g{LM + 128, (const bf16_t*)(WB + WB_WG), T, D, 256, 512, 256, 0, BIGK, 0, 0, 31, 0}; \
        gemm_phase(lds, wid, g, EpiGPost{HB, ((idx) == 0 ? VF : VB_), BON, PIN(28) + (idx) * D, PIN(29) + (idx) * D, WBUF}); \
    PH_END(P0 + 4) \
    PH_BEGIN(P0 + 5, 9) \
        const Gemm g{WBUF, (const bf16_t*)(WB + WB_WO), T, D, D, D, D, 0, BIGK, 0, 0, 31, 0}; \
        gemm_phase(lds, wid, g, EpiRes<false, false>{XB, XB}); \
    PH_END(P0 + 5) \
    FFN_PHASES(layer, P0 + 6)

    HYBRID_PHASES(0, 0, 0)
    RWKV_PHASES(1, 0, 7)
    HYBRID_PHASES(2, 1, 16)
    RWKV_PHASES(3, 1, 23)
}
}

extern "C" void kernel_launch(void* const* d_in, const int* in_sizes, int n_in, void* d_out, int out_size, void* d_ws, size_t ws_size,
                              hipStream_t stream) {
    static int grid = 0;
    if (grid == 0) {
        if (n_in != 34 || ws_size < mk::WS_END) { fprintf(stderr, "kernel_launch: unexpected n_in %d / ws_size %zu (need %zu)\n", n_in, ws_size, (size_t)mk::WS_END); grid = -1; return; }
        int dev = 0, cus = 0, per_cu = 0;
        (void)hipGetDevice(&dev); (void)hipDeviceGetAttribute(&cus, hipDeviceAttributeMultiprocessorCount, dev);
        if (hipFuncSetAttribute((const void*)mk::mk_fwd, hipFuncAttributeMaxDynamicSharedMemorySize, mk::LDS_BYTES) != hipSuccess) { fprintf(stderr, "kernel_launch: hipFuncSetAttribute failed\n"); grid = -1; return; }
        if (hipOccupancyMaxActiveBlocksPerMultiprocessor(&per_cu, (const void*)mk::mk_fwd, 512, mk::LDS_BYTES) != hipSuccess || per_cu < 1) { fprintf(stderr, "kernel_launch: occupancy query says %d\n", per_cu); per_cu = 1; }
        (void)hipGetLastError();
        grid = cus * 1;
        if (grid <= 0) grid = 256;
    }
    if (grid < 0) return;
    mk::Params p{};
    for (int i = 0; i < 34; ++i) p.in[i] = (const float*)d_in[i];
    p.out = (float*)d_out; p.ws = (unsigned char*)d_ws;
#if MK_CUT > 0
    (void)hipMemsetAsync((char*)d_ws + mk::WS_CTL, 0, 16384, stream);
#if MK_SPLIT
    for (int ph = 0; ph < MK_CUT; ++ph) { p.lo = ph; p.hi = ph + 1; hipLaunchKernelGGL(mk::mk_fwd, dim3(grid), dim3(512), mk::LDS_BYTES, stream, p); }
#else
    p.lo = 0; p.hi = MK_CUT; p.coop = 1;
    void* args[] = {&p};
    hipError_t e = hipLaunchCooperativeKernel((const void*)mk::mk_fwd, dim3(grid), dim3(512), args, mk::LDS_BYTES, stream);
    if (e != hipSuccess) fprintf(stderr, "cooperative launch failed: %s (grid %d)\n", hipGetErrorString(e), grid);
#endif
#endif
#if MK_CUT < 32
    nv::run_from(d_in, (float*)d_out, (unsigned char*)d_ws, MK_CUT, stream);
#endif
}
```
